# Optimizing an MI355X kernel written in HIP

```python
import math
import jax, jax.numpy as jnp
from jax import lax
import numpy as np

D_MODEL = 1024
BATCH = 8
SEQ = 2048
DEPTH = 1
DEC_BATCH = 128
DEC_SEQ = 8
PAST_LEN = 16384
PAGE_SIZE = 128

EPS = 1e-5
W_MIX = D_MODEL
W_CONV = W_MIX // 2
W_SSM = W_MIX - W_CONV
CONV_W = 3
SSM_H = 16
N_GROUPS = W_SSM // SSM_H
STATE_P = 64
D_FF = ((8 * D_MODEL // 3 + 255) // 256) * 256

kernel_name = 'hybrid_shortconv_s5_decode_step'


def rms_norm(x, g):
    xf = x.astype(jnp.float32)
    y = xf * lax.rsqrt(jnp.mean(xf * xf, axis=-1, keepdims=True) + EPS)
    return (y * g.astype(jnp.float32)).astype(x.dtype)


def short_conv_group(b_g, c_g, xc, conv_past, conv_w):
    L = xc.shape[1]
    v = c_g * xc
    v_ext = jnp.concatenate([conv_past.astype(v.dtype), v], axis=1)
    conv = sum(conv_w[k] * v_ext[:, k:k + L] for k in range(CONV_W))
    return b_g * conv, v_ext[:, L:]


def _ssm_combine(left, right):
    a_l, b_l = left
    a_r, b_r = right
    return a_r * a_l, a_r * b_l + b_r


def s5_group(u, h0_re, h0_im, lam_re, lam_im, log_dt, b_re, b_im, c_re, c_im, d_skip, w_glu, b_glu):
    f32 = jnp.float32
    bsz, L, _ = u.shape
    uf = u.astype(f32).reshape(bsz, L, N_GROUPS, SSM_H)
    lam = lax.complex(lam_re.astype(f32), lam_im.astype(f32))
    dt = jnp.exp(log_dt.astype(f32))[:, None]
    lam_bar = jnp.exp(lam * dt)
    b_mat = lax.complex(b_re.astype(f32), b_im.astype(f32))
    b_bar = ((lam_bar - 1.0) / lam)[..., None] * b_mat
    c_mat = lax.complex(c_re.astype(f32), c_im.astype(f32))
    bu = jnp.einsum('gph,blgh->blgp', b_bar, uf.astype(jnp.complex64))
    h0 = lax.complex(h0_re.astype(f32), h0_im.astype(f32))
    bu = bu.at[:, 0].add(lam_bar * h0)
    a = jnp.broadcast_to(lam_bar, bu.shape)
    _, h = lax.associative_scan(_ssm_combine, (a, bu), axis=1)
    y = jnp.einsum('ghp,blgp->blgh', c_mat, h).real + d_skip.astype(f32).reshape(N_GROUPS, SSM_H) * uf
    z = jax.nn.gelu(y.reshape(bsz, L, W_SSM))
    gate = jax.nn.sigmoid(z @ w_glu.astype(f32) + b_glu.astype(f32))
    out = (z * gate).astype(u.dtype)
    h_last = h[:, -1]
    return out, jnp.real(h_last).astype(h0_re.dtype), jnp.imag(h_last).astype(h0_re.dtype)


def hybrid_layer(x, conv_past, h_re, h_im, norm_mix, w_in, conv_w, lam_re, lam_im, log_dt,
                 b_re, b_im, c_re, c_im, d_skip, w_glu, b_glu, w_out,
                 norm_ffn, w_gate, w_up, w_down):
    xn = rms_norm(x, norm_mix)
    proj = xn @ w_in
    b_g, c_g, xc, u = jnp.split(proj, [W_CONV, 2 * W_CONV, 3 * W_CONV], axis=-1)
    conv_out, conv_new = short_conv_group(b_g, c_g, xc, conv_past, conv_w)
    ssm_out, hr, hi = s5_group(u, h_re, h_im, lam_re, lam_im, log_dt, b_re, b_im,
                               c_re, c_im, d_skip, w_glu, b_glu)
    x = x + jnp.concatenate([conv_out, ssm_out], axis=-1) @ w_out
    hn = rms_norm(x, norm_ffn)
    x = x + (jax.nn.silu(hn @ w_gate) * (hn @ w_up)) @ w_down
    return x, conv_new, hr, hi


def setup_inputs(seed: int = 0) -> dict:
    key = jax.random.key(seed)
    ks = jax.random.split(key, 26)
    nrm = jax.random.normal
    lam_im_base = math.pi * jnp.arange(STATE_P, dtype=jnp.float32)
    return {
        'x_prompt': nrm(ks[0], (BATCH, SEQ, D_MODEL), jnp.float32),
        'x_sample': nrm(ks[1], (DEC_BATCH, DEC_SEQ, D_MODEL), jnp.float32),
        'cache_conv': nrm(ks[2], (DEPTH, DEC_BATCH, CONV_W - 1, W_CONV), jnp.float32),
        'state_ssm_re': 0.5 * nrm(ks[3], (DEPTH, DEC_BATCH, N_GROUPS, STATE_P), jnp.float32),
        'state_ssm_im': 0.5 * nrm(ks[4], (DEPTH, DEC_BATCH, N_GROUPS, STATE_P), jnp.float32),
        'norm_mix': 1.0 + 0.02 * nrm(ks[5], (DEPTH, D_MODEL), jnp.float32),
        'w_in': nrm(ks[6], (DEPTH, D_MODEL, 3 * W_CONV + W_SSM), jnp.float32) * D_MODEL ** -0.5,
        'conv_w': nrm(ks[7], (DEPTH, CONV_W, W_CONV), jnp.float32) * CONV_W ** -0.5,
        'ssm_lam_re': -0.5 + 0.01 * nrm(ks[8], (DEPTH, N_GROUPS, STATE_P), jnp.float32),
        'ssm_lam_im': lam_im_base + 0.01 * nrm(ks[9], (DEPTH, N_GROUPS, STATE_P), jnp.float32),
        'ssm_log_dt': jax.random.uniform(ks[10], (DEPTH, N_GROUPS), jnp.float32,
                                         minval=math.log(1e-3), maxval=math.log(1e-1)),
        'ssm_b_re': nrm(ks[11], (DEPTH, N_GROUPS, STATE_P, SSM_H), jnp.float32) * (2 * SSM_H) ** -0.5,
        'ssm_b_im': nrm(ks[12], (DEPTH, N_GROUPS, STATE_P, SSM_H), jnp.float32) * (2 * SSM_H) ** -0.5,
        'ssm_c_re': nrm(ks[13], (DEPTH, N_GROUPS, SSM_H, STATE_P), jnp.float32) * STATE_P ** -0.5,
        'ssm_c_im': nrm(ks[14], (DEPTH, N_GROUPS, SSM_H, STATE_P), jnp.float32) * STATE_P ** -0.5,
        'ssm_d': nrm(ks[15], (DEPTH, W_SSM), jnp.float32),
        'w_glu': nrm(ks[16], (DEPTH, W_SSM, W_SSM), jnp.float32) * W_SSM ** -0.5,
        'b_glu': 0.01 * nrm(ks[17], (DEPTH, W_SSM), jnp.float32),
        'w_out': nrm(ks[18], (DEPTH, W_MIX, D_MODEL), jnp.float32) * W_MIX ** -0.5,
        'norm_ffn': 1.0 + 0.02 * nrm(ks[19], (DEPTH, D_MODEL), jnp.float32),
        'w_gate': nrm(ks[20], (DEPTH, D_MODEL, D_FF), jnp.float32) * D_MODEL ** -0.5,
        'w_up': nrm(ks[21], (DEPTH, D_MODEL, D_FF), jnp.float32) * D_MODEL ** -0.5,
        'w_down': nrm(ks[22], (DEPTH, D_FF, D_MODEL), jnp.float32) * D_FF ** -0.5,
        'norm_final': 1.0 + 0.02 * nrm(ks[23], (D_MODEL,), jnp.float32),
    }


def reference(x_prompt, x_sample, cache_conv, state_ssm_re, state_ssm_im,
              norm_mix, w_in, conv_w, ssm_lam_re, ssm_lam_im, ssm_log_dt,
              ssm_b_re, ssm_b_im, ssm_c_re, ssm_c_im, ssm_d, w_glu, b_glu, w_out,
              norm_ffn, w_gate, w_up, w_down, norm_final):
    bp = x_prompt.shape[0]
    xp, xs = x_prompt, x_sample
    conv_p, re_p, im_p, conv_s, re_s, im_s = [], [], [], [], [], []
    for l in range(DEPTH):
        weights = (norm_mix[l], w_in[l], conv_w[l], ssm_lam_re[l], ssm_lam_im[l], ssm_log_dt[l],
                   ssm_b_re[l], ssm_b_im[l], ssm_c_re[l], ssm_c_im[l], ssm_d[l], w_glu[l], b_glu[l],
                   w_out[l], norm_ffn[l], w_gate[l], w_up[l], w_down[l])
        zc = jnp.zeros((bp, CONV_W - 1, W_CONV), xp.dtype)
        zh = jnp.zeros((bp, N_GROUPS, STATE_P), state_ssm_re.dtype)
        xp, c_new, hr, hi = hybrid_layer(xp, zc, zh, zh, *weights)
        conv_p.append(c_new); re_p.append(hr); im_p.append(hi)
        xs, c_new, hr, hi = hybrid_layer(xs, cache_conv[l], state_ssm_re[l], state_ssm_im[l], *weights)
        conv_s.append(c_new); re_s.append(hr); im_s.append(hi)
    y_prompt = rms_norm(xp, norm_final)
    y_sample = rms_norm(xs, norm_final)
    return (y_prompt, y_sample,
            jnp.stack(conv_p), jnp.stack(re_p), jnp.stack(im_p),
            jnp.stack(conv_s), jnp.stack(re_s), jnp.stack(im_s))
```

```cpp
#include <hip/hip_runtime.h>
#include <hip/hip_cooperative_groups.h>
#include <cstdio>
#include <cstdint>
namespace pg8 {
#define PG8_LAS __attribute__((address_space(3)))
typedef unsigned short bf16_t;
typedef short bf16x8 __attribute__((ext_vector_type(8)));
typedef float f32x4 __attribute__((ext_vector_type(4)));
typedef unsigned u32x4 __attribute__((ext_vector_type(4)));
constexpr int BM = 256, BK = 64, HALF = 128, HTB = HALF * BK * 2  , STAGE_BYTES = 8 * HTB, NXCD = 8, WGM = 8;

__host__ __device__ __forceinline__ int lds_byte(int r, int c) { const int st = (r >> 4) * 2 + (c >> 5), rr = r & 15, cc = c & 31, ob = rr * 64 + cc * 2; return st * 1024 + (ob ^ (((ob >> 9) & 1) << 5)); }
__host__ __device__ __forceinline__ void stage_rc(int b, int& R, int& C) { const int st = b / 1024, sb = b % 1024, swz = sb ^ (((sb >> 9) & 1) << 5); R = (st >> 1) * 16 + swz / 64; C = (st & 1) * 32 + (swz % 64) / 2; }
__host__ __device__ __forceinline__ int perm32(int rho) { const int n = rho >> 4, i = rho & 15; return 8 * (i >> 2) + 4 * n + (i & 3); }

struct Unit { int pm, pn; };
struct Gemm { const bf16_t* A; const bf16_t* Bt; int M, N, K; };

struct StaticOrder {
    int nM, nN, nwg, G, c;
    __host__ __device__ void init(int M, int N, int G_, int c_) { nM = M / BM; nN = N / BM; nwg = nM * nN; G = G_; c = c_; }
    __host__ __device__ bool next(int i, Unit& u) const {
        const long L = (long)i * G + c; if (L >= nwg) return false;
        int wgid = (int)L; { const int q = nwg / NXCD, r = nwg % NXCD, xcd = wgid % NXCD, off = wgid / NXCD; wgid = (xcd < r ? xcd * (q + 1) : r * (q + 1) + (xcd - r) * q) + off; }
        const int nig = WGM * nN, gid = wgid / nig, fm = gid * WGM, gsz = (nM - fm) < WGM ? (nM - fm) : WGM;
        u.pm = fm + ((wgid % nig) % gsz); u.pn = (wgid % nig) / gsz; return true;
    }
    __device__ __forceinline__ void a_ready(const Unit&) const {}
    __device__ __forceinline__ void done(const Unit&) const {}
};

__device__ __forceinline__ unsigned cvt_pk_bf16(float lo, float hi) { unsigned r; asm volatile("v_cvt_pk_bf16_f32 %0, %1, %2" : "=v"(r) : "v"(lo), "v"(hi)); return r; }
typedef float f32x2 __attribute__((ext_vector_type(2)));
constexpr int MTOT = 17408;
__device__ __forceinline__ float bf_lo(unsigned w) { return __uint_as_float(w << 16); }
__device__ __forceinline__ float bf_hi(unsigned w) { return __uint_as_float(w & 0xffff0000u); }
__device__ __forceinline__ float sigmoidf_fast(float a) { return __builtin_amdgcn_rcpf(1.0f + __expf(-a)); }
__device__ __forceinline__ u32x4 pack8(const f32x4 v0, const f32x4 v1) { u32x4 w; w.x = cvt_pk_bf16(v0[0], v0[1]); w.y = cvt_pk_bf16(v0[2], v0[3]); w.z = cvt_pk_bf16(v1[0], v1[1]); w.w = cvt_pk_bf16(v1[2], v1[3]); return w; }

struct EpiProj {
    static constexpr bool PERM = true, AFTER_DRAIN = false;
    bf16_t* BG; bf16_t* V; bf16_t* UG;
    __device__ __forceinline__ void operator()(const f32x4 (&acc)[2][2][4][2], const Unit& u, int wr, int wc, int fr, int fq) const {
        const int row0 = u.pm * BM + wr * 64 + fr, pn = u.pn;
        if (pn >= 2 && pn < 6) {
            const int col = 128 * (pn - 2) + 32 * wc + 8 * fq;
#pragma unroll
            for (int ai = 0; ai < 2; ++ai)
#pragma unroll
                for (int m = 0; m < 4; ++m) { const int row = row0 + ai * HALF + m * 16;
                    const f32x4 v0 = acc[ai][0][m][0] * acc[ai][1][m][0], v1 = acc[ai][0][m][1] * acc[ai][1][m][1];
                    *(u32x4*)(V + (size_t)row * 512 + col) = pack8(v0, v1); }
        } else if (pn < 2) {
#pragma unroll
            for (int ai = 0; ai < 2; ++ai)
#pragma unroll
                for (int m = 0; m < 4; ++m) { const int row = row0 + ai * HALF + m * 16;
#pragma unroll
                    for (int bj = 0; bj < 2; ++bj) *(u32x4*)(BG + (size_t)row * 512 + 256 * pn + 128 * bj + 32 * wc + 8 * fq) = pack8(acc[ai][bj][m][0], acc[ai][bj][m][1]); }
        } else {
#pragma unroll
            for (int ai = 0; ai < 2; ++ai)
#pragma unroll
                for (int m = 0; m < 4; ++m) { const int row = row0 + ai * HALF + m * 16;
#pragma unroll
                    for (int bj = 0; bj < 2; ++bj) { const int cu = 256 * (pn - 6) + 128 * bj + 32 * wc + 8 * fq;
                        *(u32x4*)(UG + ((size_t)(cu >> 4) * MTOT + row) * 16 + (cu & 15)) = pack8(acc[ai][bj][m][0], acc[ai][bj][m][1]); } }
        }
    }
};
struct EpiGlu {
    static constexpr bool PERM = true, AFTER_DRAIN = false;
    const bf16_t* Z; const float* bias; bf16_t* MIX;
    __device__ __forceinline__ void operator()(const f32x4 (&acc)[2][2][4][2], const Unit& u, int wr, int wc, int fr, int fq) const {
        const int row0 = u.pm * BM + wr * 64 + fr;
#pragma unroll
        for (int bj = 0; bj < 2; ++bj) { const int col = 256 * u.pn + 128 * bj + 32 * wc + 8 * fq;
            const f32x4 b0 = *(const f32x4*)(bias + col), b1 = *(const f32x4*)(bias + col + 4);
#pragma unroll
            for (int ai = 0; ai < 2; ++ai)
#pragma unroll
                for (int m = 0; m < 4; ++m) { const int row = row0 + ai * HALF + m * 16;
                    const u32x4 zz = *(const u32x4*)(Z + (size_t)row * 512 + col);
                    const f32x4 a0 = acc[ai][bj][m][0] + b0, a1 = acc[ai][bj][m][1] + b1;
                    f32x4 o0, o1;
                    o0[0] = bf_lo(zz.x) * sigmoidf_fast(a0[0]); o0[1] = bf_hi(zz.x) * sigmoidf_fast(a0[1]); o0[2] = bf_lo(zz.y) * sigmoidf_fast(a0[2]); o0[3] = bf_hi(zz.y) * sigmoidf_fast(a0[3]);
                    o1[0] = bf_lo(zz.z) * sigmoidf_fast(a1[0]); o1[1] = bf_hi(zz.z) * sigmoidf_fast(a1[1]); o1[2] = bf_lo(zz.w) * sigmoidf_fast(a1[2]); o1[3] = bf_hi(zz.w) * sigmoidf_fast(a1[3]);
                    *(u32x4*)(MIX + (size_t)row * 1024 + 512 + col) = pack8(o0, o1); } }
    }
};
constexpr float SS_SCALE = 16777216.0f;
template <bool WITH_BF16> struct EpiRes {
    static constexpr bool PERM = true, AFTER_DRAIN = false;
    const float* xp; const float* xs; float* xo; bf16_t* xb; unsigned long long* SS;
    __device__ __forceinline__ void operator()(const f32x4 (&acc)[2][2][4][2], const Unit& u, int wr, int wc, int fr, int fq) const {
        const int row0 = u.pm * BM + wr * 64 + fr;
        const float* xi = (u.pm < 64) ? xp : xs - (size_t)16384 * 1024;
#pragma unroll
        for (int ai = 0; ai < 2; ++ai)
#pragma unroll
            for (int m = 0; m < 4; ++m) { const int row = row0 + ai * HALF + m * 16; float ss = 0.f;
#pragma unroll
                for (int bj = 0; bj < 2; ++bj) { const size_t off = (size_t)row * 1024 + 256 * u.pn + 128 * bj + 32 * wc + 8 * fq;
                    const f32x4 v0 = *(const f32x4*)(xi + off) + acc[ai][bj][m][0], v1 = *(const f32x4*)(xi + off + 4) + acc[ai][bj][m][1];
                    ss += (v0[0] * v0[0] + v0[1] * v0[1]) + (v0[2] * v0[2] + v0[3] * v0[3]) + (v1[0] * v1[0] + v1[1] * v1[1]) + (v1[2] * v1[2] + v1[3] * v1[3]);
                    *(f32x4*)(xo + off) = v0; *(f32x4*)(xo + off + 4) = v1;
                    if (WITH_BF16) *(u32x4*)(xb + off) = pack8(v0, v1); }
                ss += __shfl_xor(ss, 16); ss += __shfl_xor(ss, 32);
                if (fq == 0) atomicAdd(SS + row, (unsigned long long)(ss * SS_SCALE + 0.5f)); }
    }
};
struct EpiFfn1 {
    static constexpr bool PERM = true, AFTER_DRAIN = false;
    const unsigned long long* SS; bf16_t* H;
    __device__ __forceinline__ void operator()(const f32x4 (&acc)[2][2][4][2], const Unit& u, int wr, int wc, int fr, int fq) const {
        const int row0 = u.pm * BM + wr * 64 + fr, col = 128 * u.pn + 32 * wc + 8 * fq;
#pragma unroll
        for (int ai = 0; ai < 2; ++ai)
#pragma unroll
            for (int m = 0; m < 4; ++m) { const int row = row0 + ai * HALF + m * 16;
                const float rs = __builtin_amdgcn_rsqf((float)SS[row] * (1.0f / (SS_SCALE * 1024.0f)) + 1e-5f);
                f32x4 o[2];
#pragma unroll
                for (int n = 0; n < 2; ++n)
#pragma unroll
                    for (int i = 0; i < 4; ++i) { const float g = acc[ai][0][m][n][i] * rs, uu = acc[ai][1][m][n][i] * rs; o[n][i] = g * sigmoidf_fast(g) * uu; }
                *(u32x4*)(H + (size_t)row * 2816 + col) = pack8(o[0], o[1]); }
    }
};
template <class Epi, class Sched, bool ALIGN_EPI = false, bool SP2 = false>
__device__ __forceinline__ void gemm_phase(PG8_LAS unsigned char* lds, const Gemm g, const Sched& S, const Epi& E) {
    const int tid = threadIdx.x, wid = __builtin_amdgcn_readfirstlane(tid >> 6), lane = tid & 63, wr = wid >> 2, wc = wid & 3, fr = lane & 15, fq = lane >> 4;
    const int K = g.K, nt = K / BK;
    unsigned voffA[2], voffB[2];
#pragma unroll
    for (int i = 0; i < 2; ++i) { int R, C; stage_rc(tid * 16 + i * 8192, R, C); const int Rb = Epi::PERM ? ((R & ~31) + perm32(R & 31)) : R;
        voffA[i] = (unsigned)(R * K + C) * 2u; voffB[i] = (unsigned)(Rb * K + C) * 2u; }
    const size_t kstep = (size_t)(BK * 2);
    const size_t hstep = (size_t)HALF * K * 2;
    const size_t tstep = 2 * hstep;
    const unsigned ldsw = (unsigned)wid * 1024u;
    const int aoff = lds_byte(wr * 64 + fr, fq * 8), boff = lds_byte(wc * 32 + fr, fq * 8);
#define PG8_SA(b, h) (((b) * 2 + (h)) * HTB)
#define PG8_SB(b, h) ((4 + (b) * 2 + (h)) * HTB)
#define PG8_STAGE(bufoff, gbase, voff) do { _Pragma("unroll") for (int _i = 0; _i < 2; ++_i) \
        __builtin_amdgcn_global_load_lds((const unsigned*)((const char*)(gbase) + (voff)[_i]), (PG8_LAS unsigned*)(lds + (bufoff) + ldsw + _i * 8192), 16, 0, 0); } while (0)
#define PG8_LDA(dst, b, h) do { _Pragma("unroll") for (int m = 0; m < 4; ++m) _Pragma("unroll") for (int k = 0; k < 2; ++k) dst[m][k] = *(const PG8_LAS bf16x8*)(lds + PG8_SA(b, h) + aoff + m * 2048 + k * 1024); } while (0)
#define PG8_LDB(dst, b, h) do { _Pragma("unroll") for (int n = 0; n < 2; ++n) _Pragma("unroll") for (int k = 0; k < 2; ++k) dst[n][k] = *(const PG8_LAS bf16x8*)(lds + PG8_SB(b, h) + boff + n * 2048 + k * 1024); } while (0)
#define PG8_MMA(ai, bj, At, Bt) do { __builtin_amdgcn_s_setprio(1); _Pragma("unroll") for (int m = 0; m < 4; ++m) _Pragma("unroll") for (int n = 0; n < 2; ++n) _Pragma("unroll") for (int k = 0; k < 2; ++k) \
        acc[ai][bj][m][n] = __builtin_amdgcn_mfma_f32_16x16x32_bf16(Bt[n][k], At[m][k], acc[ai][bj][m][n], 0, 0, 0); __builtin_amdgcn_s_setprio(0); } while (0)
#define PG8_WAIT_V(n) asm volatile("s_waitcnt vmcnt(" #n ")" ::: "memory")
#define PG8_WAIT_L(n) asm volatile("s_waitcnt lgkmcnt(" #n ")" ::: "memory")
#define PG8_BAR __builtin_amdgcn_s_barrier()
#define PG8_SCHED __builtin_amdgcn_sched_barrier(0)
    Unit cur, nxt; int ui = 0;
    if (!S.next(0, cur)) return;
    f32x4 acc[2][2][4][2];
#pragma unroll
    for (int a = 0; a < 2; ++a)
#pragma unroll
        for (int b = 0; b < 2; ++b)
#pragma unroll
            for (int m = 0; m < 4; ++m)
#pragma unroll
                for (int n = 0; n < 2; ++n) acc[a][b][m][n] = (f32x4){0.f, 0.f, 0.f, 0.f};
    bf16x8 At[4][2], B0[2][2], B1[2][2];
    const char* cA = (const char*)g.A + (size_t)cur.pm * tstep; const char* cB = (const char*)g.Bt + (size_t)cur.pn * tstep;
    S.a_ready(cur);
    if constexpr (SP2) {
        PG8_STAGE(PG8_SB(0, 0), cB, voffB); PG8_STAGE(PG8_SB(0, 1), cB + hstep, voffB); PG8_STAGE(PG8_SA(0, 0), cA, voffA); PG8_STAGE(PG8_SA(0, 1), cA + hstep, voffA);
        if (wr == 1) PG8_BAR;
        PG8_WAIT_V(2); PG8_BAR;
        PG8_STAGE(PG8_SB(1, 0), cB + kstep, voffB); PG8_STAGE(PG8_SA(1, 0), cA + kstep, voffA); PG8_STAGE(PG8_SB(1, 1), cB + hstep + kstep, voffB);
        PG8_WAIT_V(6); PG8_BAR;
    } else {
        PG8_STAGE(PG8_SB(0, 0), cB, voffB); PG8_STAGE(PG8_SA(0, 0), cA, voffA); PG8_STAGE(PG8_SB(0, 1), cB + hstep, voffB); PG8_STAGE(PG8_SA(0, 1), cA + hstep, voffA);
        if (wr == 1) PG8_BAR;
        PG8_WAIT_V(4); PG8_BAR;
        PG8_STAGE(PG8_SB(1, 0), cB + kstep, voffB); PG8_STAGE(PG8_SA(1, 0), cA + kstep, voffA); PG8_STAGE(PG8_SB(1, 1), cB + hstep + kstep, voffB);
        PG8_WAIT_V(6); PG8_BAR;
    }
    for (;;) {
        const bool has_next = S.next(ui + 1, nxt);
        const char* nA = has_next ? (const char*)g.A + (size_t)nxt.pm * tstep : cA; const char* nB = has_next ? (const char*)g.Bt + (size_t)nxt.pn * tstep : cB;
        for (int t = 0; t < nt; t += 2) {
            const bool last = (t == nt - 2);
            const char* a1 = cA + (size_t)(t + 1) * kstep;
            const char* a2 = last ? nA : cA + (size_t)(t + 2) * kstep; const char* b2 = last ? nB : cB + (size_t)(t + 2) * kstep;
            const char* a3 = a2 + kstep; const char* b3 = b2 + kstep;
            if (last && has_next) S.a_ready(nxt);
            if constexpr (SP2) {
            PG8_LDB(B0, 0, 0); PG8_LDB(B1, 0, 1); PG8_SCHED; PG8_LDA(At, 0, 0); PG8_STAGE(PG8_SA(1, 1), a1 + hstep, voffA);
            PG8_WAIT_V(8); PG8_WAIT_L(0); PG8_BAR; PG8_MMA(0, 0, At, B0); PG8_MMA(0, 1, At, B1); PG8_BAR; PG8_SCHED;
            PG8_LDA(At, 0, 1); PG8_STAGE(PG8_SB(0, 0), b2, voffB); PG8_STAGE(PG8_SB(0, 1), b2 + hstep, voffB); PG8_STAGE(PG8_SA(0, 0), a2, voffA);
            PG8_WAIT_V(8); PG8_WAIT_L(0); PG8_BAR; PG8_MMA(1, 0, At, B0); PG8_MMA(1, 1, At, B1); PG8_BAR; PG8_SCHED;
            PG8_LDB(B0, 1, 0); PG8_LDB(B1, 1, 1); PG8_SCHED; PG8_LDA(At, 1, 0); PG8_STAGE(PG8_SA(0, 1), a2 + hstep, voffA);
            PG8_WAIT_V(8); PG8_WAIT_L(0); PG8_BAR; PG8_MMA(0, 0, At, B0); PG8_MMA(0, 1, At, B1); PG8_BAR; PG8_SCHED;
            PG8_LDA(At, 1, 1); PG8_STAGE(PG8_SB(1, 0), b3, voffB); PG8_STAGE(PG8_SB(1, 1), b3 + hstep, voffB); PG8_STAGE(PG8_SA(1, 0), a3, voffA);
            PG8_WAIT_V(8); PG8_WAIT_L(0); PG8_BAR; PG8_MMA(1, 0, At, B0); PG8_MMA(1, 1, At, B1); PG8_BAR; PG8_SCHED;
            } else {
            PG8_LDB(B0, 0, 0); PG8_SCHED; PG8_LDA(At, 0, 0); PG8_STAGE(PG8_SA(1, 1), a1 + hstep, voffA);
            PG8_WAIT_L(8); PG8_BAR; PG8_WAIT_L(0); PG8_MMA(0, 0, At, B0); PG8_BAR; PG8_SCHED;
            PG8_LDB(B1, 0, 1); PG8_STAGE(PG8_SB(0, 0), b2, voffB);
            PG8_BAR; PG8_WAIT_L(0); PG8_MMA(0, 1, At, B1); PG8_BAR;
            PG8_LDA(At, 0, 1); PG8_STAGE(PG8_SA(0, 0), a2, voffA);
            PG8_BAR; PG8_WAIT_L(0); PG8_MMA(1, 0, At, B0); PG8_BAR; PG8_SCHED;
            PG8_STAGE(PG8_SB(0, 1), b2 + hstep, voffB);
            PG8_WAIT_V(6); PG8_BAR; PG8_MMA(1, 1, At, B1); PG8_BAR;
            PG8_LDB(B0, 1, 0); PG8_SCHED; PG8_LDA(At, 1, 0); PG8_STAGE(PG8_SA(0, 1), a2 + hstep, voffA);
            PG8_WAIT_L(8); PG8_BAR; PG8_WAIT_L(0); PG8_MMA(0, 0, At, B0); PG8_BAR; PG8_SCHED;
            PG8_LDB(B1, 1, 1); PG8_STAGE(PG8_SB(1, 0), b3, voffB);
            PG8_BAR; PG8_WAIT_L(0); PG8_MMA(0, 1, At, B1); PG8_BAR;
            PG8_LDA(At, 1, 1); PG8_STAGE(PG8_SA(1, 0), a3, voffA);
            PG8_BAR; PG8_WAIT_L(0); PG8_MMA(1, 0, At, B0); PG8_BAR; PG8_SCHED;
            PG8_STAGE(PG8_SB(1, 1), b3 + hstep, voffB);
            PG8_WAIT_V(6); PG8_BAR; PG8_MMA(1, 1, At, B1); PG8_BAR;
            }
        }
        if constexpr (ALIGN_EPI) { if (wr == 0) PG8_BAR; }
        if constexpr (!Epi::AFTER_DRAIN) { E(acc, cur, wr, wc, fr, fq); S.done(cur); }
        if (!has_next) break;
#pragma unroll
        for (int a = 0; a < 2; ++a)
#pragma unroll
            for (int b = 0; b < 2; ++b)
#pragma unroll
                for (int m = 0; m < 4; ++m)
#pragma unroll
                    for (int n = 0; n < 2; ++n) acc[a][b][m][n] = (f32x4){0.f, 0.f, 0.f, 0.f};
        cur = nxt; cA = nA; cB = nB; ++ui;
        if constexpr (ALIGN_EPI) { if (wr == 1) PG8_BAR; }
    }
    PG8_WAIT_V(0);
    if constexpr (!ALIGN_EPI) { if (wr == 0) PG8_BAR; }
    PG8_BAR;
    if constexpr (Epi::AFTER_DRAIN) { E.fused(acc, cur, wr, wc, fr, fq, lds, wid, lane); S.done(cur); }
#undef PG8_SA
#undef PG8_SB
#undef PG8_STAGE
#undef PG8_LDA
#undef PG8_LDB
#undef PG8_MMA
#undef PG8_WAIT_V
#undef PG8_WAIT_L
#undef PG8_BAR
#undef PG8_SCHED
}
}
namespace cg = cooperative_groups;
#define LAS __attribute__((address_space(3)))
typedef unsigned short bf16;
typedef unsigned v4u __attribute__((ext_vector_type(4)));
typedef unsigned v2u __attribute__((ext_vector_type(2)));
typedef float f32x4 __attribute__((ext_vector_type(4)));
typedef short bf16x8 __attribute__((ext_vector_type(8)));
constexpr int NWAVES = 8, NTHR = 512;
constexpr int D = 1024, MP = 16384, MS = 1024, MTOT = MP + MS, SEQ = 2048, DSEQ = 8, NB = 8, NDB = 128;
constexpr int WC = 512, WS_ = 512, NG = 32, SP = 64, SH = 16, DFF = 2816, NPROJ = 2048, NGU = 2 * DFF;
constexpr float EPS = 1e-5f;
constexpr size_t MiB = 1u << 20;
constexpr size_t WS_SS1 = 0, WS_SS2 = 256 * 1024;
constexpr size_t WS_WIN = 1 * MiB, WS_WGLU = 5 * MiB, WS_WOUT = 6 * MiB, WS_WGU = 8 * MiB, WS_WDN = 19 * MiB + 512 * 1024;
constexpr size_t WS_E = 25 * MiB, WS_B3 = 26 * MiB;
constexpr size_t WS_XN = 28 * MiB;
constexpr size_t WS_BG = 62 * MiB, WS_V = 79 * MiB, WS_UG = 96 * MiB, WS_Z = 113 * MiB, WS_MIX = 130 * MiB;
constexpr size_t WS_H = 62 * MiB;
constexpr size_t WS_END = 164 * MiB;
static_assert(WS_WGU + (size_t)NGU * D * 2 <= WS_WDN && WS_WDN + (size_t)D * DFF * 2 <= WS_E && WS_B3 + (size_t)NG * 128 * 256 * 2 <= WS_XN, "ws map");
static_assert(WS_XN + (size_t)MTOT * D * 2 <= WS_BG && WS_BG + (size_t)MTOT * 512 * 2 <= WS_V && WS_MIX + (size_t)MTOT * D * 2 <= WS_END && WS_H + (size_t)MTOT * DFF * 2 <= WS_END, "ws map");
constexpr size_t O_Y = 0, O_CONVP = (size_t)MTOT * D, O_REP = O_CONVP + 8192, O_IMP = O_REP + 16384, O_CONVS = O_IMP + 16384, O_RES = O_CONVS + 131072, O_IMS = O_RES + 262144, O_END = O_IMS + 262144;
constexpr int LDS_BYTES = 147456;

struct Params { const float* in[24]; float* out; unsigned char* ws; };
enum { I_XP = 0, I_XS, I_CCONV, I_SRE, I_SIM, I_NMIX, I_WIN, I_CONVW, I_LRE, I_LIM, I_LDT, I_BRE, I_BIM, I_CRE, I_CIM, I_DSK, I_WGLU, I_BGLU, I_WOUT, I_NFFN, I_WGATE, I_WUP, I_WDN, I_NFIN };

__device__ __forceinline__ unsigned f2bf(float f) { unsigned u = __builtin_bit_cast(unsigned, f); return (u + 0x7fffu + ((u >> 16) & 1u)) >> 16; }
__device__ __forceinline__ unsigned pk2(float lo, float hi) { return f2bf(lo) | (f2bf(hi) << 16); }
__device__ __forceinline__ float wave_sum(float v) {
#pragma unroll
    for (int o = 1; o < 64; o <<= 1) v += __shfl_xor(v, o);
    return v;
}
#define LDS_WAIT() asm volatile("s_waitcnt lgkmcnt(0)" ::: "memory")

__device__ __forceinline__ void transpose_item(const float* W, int N, int K, int k0, int srccol0, bf16* WT, int dstrow0, const float* ksc, LAS float* scr, int lane) {
#pragma unroll 8
    for (int i = 0; i < 32; ++i) { const int kk = 2 * i + (lane >> 5); float v = W[(size_t)(k0 + kk) * N + srccol0 + (lane & 31)]; if (ksc) v *= ksc[k0 + kk]; scr[kk * 33 + (lane & 31)] = v; }
    LDS_WAIT(); asm volatile("" ::: "memory");
    const int c = lane & 7;
#pragma unroll
    for (int j = 0; j < 4; ++j) { const int n = (lane >> 3) + 8 * j; const LAS float* s = scr + (8 * c) * 33 + n;
        v4u o; o.x = pk2(s[0 * 33], s[1 * 33]); o.y = pk2(s[2 * 33], s[3 * 33]); o.z = pk2(s[4 * 33], s[5 * 33]); o.w = pk2(s[6 * 33], s[7 * 33]);
        *(v4u*)(WT + (size_t)(dstrow0 + n) * K + k0 + 8 * c) = o; }
    LDS_WAIT(); asm volatile("" ::: "memory");
}
__device__ __forceinline__ void ssm_mats_item(const Params& P, int g, int tau, bf16* E, bf16* B3, LAS float* scr, int lane) {
    const int p = lane;
    const float dt = expf(P.in[I_LDT][g]);
    const float lr = P.in[I_LRE][g * 64 + p], li = P.in[I_LIM][g * 64 + p];
    const float a = lr * dt, bb = li * dt;
    float sb, cb; sincosf(bb, &sb, &cb);
    const float ea = expf(a), em1 = expm1f(a), sh = sinf(0.5f * bb);
    const float nr = em1 * cb - 2.0f * sh * sh, ni = ea * sb;
    const float den = lr * lr + li * li;
    const float cr = (nr * lr + ni * li) / den, ci = (ni * lr - nr * li) / den;
    float st, ct; sincosf(bb * (float)tau, &st, &ct); const float et = expf(a * (float)tau);
    const float pr = et * ct, pi = et * st;
    const float wr = pr * cr - pi * ci, wi = pr * ci + pi * cr;
    bf16* Eg = E + (size_t)g * 128 * 128; bf16* Bg = B3 + (size_t)g * 128 * 256;
    {
        unsigned er[8], ei[8]; float pw_r = 0.f, pw_i = 0.f;
#pragma unroll
        for (int h = 0; h < 16; ++h) { const float br = P.in[I_BRE][(size_t)(g * 64 + p) * 16 + h], bi = P.in[I_BIM][(size_t)(g * 64 + p) * 16 + h];
            const float Wr = wr * br - wi * bi, Wi = wr * bi + wi * br;
            scr[(h * 64 + p) * 2 + 0] = Wr; scr[(h * 64 + p) * 2 + 1] = Wi;
            if (h & 1) { er[h >> 1] = pk2(pw_r, Wr); ei[h >> 1] = pk2(pw_i, Wi); } else { pw_r = Wr; pw_i = Wi; } }
        v4u* dr = (v4u*)(Eg + (size_t)p * 128 + 16 * (7 - tau)); v4u* di = (v4u*)(Eg + (size_t)(64 + p) * 128 + 16 * (7 - tau));
        dr[0] = (v4u){er[0], er[1], er[2], er[3]}; dr[1] = (v4u){er[4], er[5], er[6], er[7]};
        di[0] = (v4u){ei[0], ei[1], ei[2], ei[3]}; di[1] = (v4u){ei[4], ei[5], ei[6], ei[7]};
    }
    {
        float s1, c1; sincosf(bb * (float)(tau + 1), &s1, &c1); const float e1 = expf(a * (float)(tau + 1));
        const float qr = e1 * c1, qi = e1 * s1;
#pragma unroll 4
        for (int h = 0; h < 16; ++h) { const float Cr = P.in[I_CRE][(size_t)(g * 16 + h) * 64 + p], Ci = P.in[I_CIM][(size_t)(g * 16 + h) * 64 + p];
            Bg[(size_t)(16 * tau + h) * 256 + 128 + p] = (bf16)f2bf(Cr * qr - Ci * qi);
            Bg[(size_t)(16 * tau + h) * 256 + 192 + p] = (bf16)f2bf(-(Cr * qi + Ci * qr)); }
    }
    LDS_WAIT(); asm volatile("" ::: "memory");
    {
        const int h = lane >> 2, hq = 4 * (lane & 3);
        float k0 = 0.f, k1 = 0.f, k2 = 0.f, k3 = 0.f;
        const float* cre = P.in[I_CRE] + (size_t)(g * 16 + h) * 64; const float* cim = P.in[I_CIM] + (size_t)(g * 16 + h) * 64;
#pragma unroll 8
        for (int q = 0; q < 64; ++q) { const float Cr = cre[q], Ci = cim[q]; const LAS float* w = scr + (hq * 64 + q) * 2;
            k0 += Cr * w[0] - Ci * w[1]; k1 += Cr * w[128] - Ci * w[129]; k2 += Cr * w[256] - Ci * w[257]; k3 += Cr * w[384] - Ci * w[385]; }
        if (tau == 0) { const float dsk = P.in[I_DSK][g * 16 + h]; if (hq == (h & ~3)) { const int j = h & 3; if (j == 0) k0 += dsk; else if (j == 1) k1 += dsk; else if (j == 2) k2 += dsk; else k3 += dsk; } }
        const v2u kv = (v2u){pk2(k0, k1), pk2(k2, k3)}, zv = (v2u){0u, 0u};
        for (int t = tau; t < 8; ++t) *(v2u*)(Bg + (size_t)(16 * t + h) * 256 + 16 * (t - tau) + hq) = kv;
        if (tau >= 1) for (int t = 0; t + tau < 8; ++t) *(v2u*)(Bg + (size_t)(16 * t + h) * 256 + 16 * (t + tau) + hq) = zv;
    }
    LDS_WAIT(); asm volatile("" ::: "memory");
}
__device__ __forceinline__ void rms_row_to_bf16(const float* xrow, const float* gw, bf16* orow, int lane) {
    const f32x4* xr = (const f32x4*)xrow + lane; const f32x4* gr = (const f32x4*)gw + lane;
    f32x4 v[4]; float s = 0.f;
#pragma unroll
    for (int j = 0; j < 4; ++j) { v[j] = xr[64 * j]; s += (v[j].x * v[j].x + v[j].y * v[j].y) + (v[j].z * v[j].z + v[j].w * v[j].w); }
    const float rstd = 1.0f / sqrtf(wave_sum(s) * (1.f / D) + EPS);
    unsigned long long* o8 = (unsigned long long*)orow + lane;
#pragma unroll
    for (int j = 0; j < 4; ++j) { const f32x4 gg = gr[64 * j]; o8[64 * j] = (unsigned long long)pk2(v[j].x * rstd * gg.x, v[j].y * rstd * gg.y) | ((unsigned long long)pk2(v[j].z * rstd * gg.z, v[j].w * rstd * gg.w) << 32); }
}
__device__ __forceinline__ void p0_prologue(const Params& P, LAS unsigned char* lds, int vcu, int G) {
    const int tid = threadIdx.x, lane = tid & 63, wave = __builtin_amdgcn_readfirstlane(tid >> 6);
    LAS float* scr = (LAS float*)(lds + wave * 16384);
    const int gw = vcu * NWAVES + wave, NGW = G * NWAVES;
    unsigned char* ws = P.ws;
    for (int i = gw * 64 + lane; i < 2 * 32768; i += NGW * 64) ((unsigned long long*)(ws + WS_SS1))[i] = 0ull;
    constexpr int I_IN = (D / 64) * (NPROJ / 32), I_GLU = (512 / 64) * (512 / 32), I_OUT = (D / 64) * (D / 32), I_GU = (D / 64) * (NGU / 32), I_DN = (DFF / 64) * (D / 32), I_SSM = NG * 8;
    constexpr int NITEMS = I_SSM + I_IN + I_GLU + I_OUT + I_GU + I_DN;
    for (int it = gw; it < NITEMS; it += NGW) {
        int r = it;
        if (r < I_SSM) { ssm_mats_item(P, r >> 3, r & 7, (bf16*)(ws + WS_E), (bf16*)(ws + WS_B3), scr, lane); continue; } r -= I_SSM;
        if (r < I_IN) { const int nblk = NPROJ / 32, kb = r / nblk, nb = r % nblk, n0 = 32 * nb; int src = n0;
            if (n0 >= 512 && n0 < 1536) { const int j = (n0 - 512) >> 8, w = (n0 - 512) & 255; src = (w < 128) ? 512 + 128 * j + w : 1024 + 128 * j + (w - 128); }
            transpose_item(P.in[I_WIN], NPROJ, D, 64 * kb, src, (bf16*)(ws + WS_WIN), n0, nullptr, scr, lane); continue; } r -= I_IN;
        if (r < I_GLU) { const int nblk = 512 / 32, kb = r / nblk, nb = r % nblk; transpose_item(P.in[I_WGLU], 512, 512, 64 * kb, 32 * nb, (bf16*)(ws + WS_WGLU), 32 * nb, nullptr, scr, lane); continue; } r -= I_GLU;
        if (r < I_OUT) { const int nblk = D / 32, kb = r / nblk, nb = r % nblk; transpose_item(P.in[I_WOUT], D, D, 64 * kb, 32 * nb, (bf16*)(ws + WS_WOUT), 32 * nb, nullptr, scr, lane); continue; } r -= I_OUT;
        if (r < I_GU) { const int nblk = NGU / 32, kb = r / nblk, nb = r % nblk, n0 = 32 * nb, j = n0 >> 8, w = n0 & 255;
            const float* src = (w < 128) ? P.in[I_WGATE] : P.in[I_WUP]; const int sc = 128 * j + (w & 127);
            transpose_item(src, DFF, D, 64 * kb, sc, (bf16*)(ws + WS_WGU), n0, P.in[I_NFFN], scr, lane); continue; } r -= I_GU;
        { const int nblk = D / 32, kb = r / nblk, nb = r % nblk; transpose_item(P.in[I_WDN], D, DFF, 64 * kb, 32 * nb, (bf16*)(ws + WS_WDN), 32 * nb, nullptr, scr, lane); }
    }
    bf16* XN = (bf16*)(ws + WS_XN);
    for (int m = gw; m < MTOT; m += NGW) { const float* xr = (m < MP) ? P.in[I_XP] + (size_t)m * D : P.in[I_XS] + (size_t)(m - MP) * D; rms_row_to_bf16(xr, P.in[I_NMIX], XN + (size_t)m * D, lane); }
}

constexpr int HL_LD = 132, HP_LD = 136;
__device__ __forceinline__ float gelu_tanh(float y) { const float t = 1.5957691216057308f * (y + 0.044715f * y * y * y); return y * __builtin_amdgcn_rcpf(1.0f + __expf(-t)); }
__device__ __forceinline__ void ssm_phase(const Params& P, LAS unsigned char* lds, int G) {
    const int tid = threadIdx.x, lane = tid & 63, wid = __builtin_amdgcn_readfirstlane(tid >> 6), fr = lane & 15, fq = lane >> 4;
    LAS float* Hl = (LAS float*)lds;
    LAS bf16* Hp = (LAS bf16*)(lds + 64 * HL_LD * 4);
    unsigned char* ws = P.ws;
    const bf16* E = (const bf16*)(ws + WS_E); const bf16* B3 = (const bf16*)(ws + WS_B3); const bf16* UG = (const bf16*)(ws + WS_UG); bf16* Z = (bf16*)(ws + WS_Z);
    for (int unit = blockIdx.x; unit < NB * NG; unit += G) {
        const int b = unit >> 5, g = unit & 31, p = lane;
        const float dt = expf(P.in[I_LDT][g]);
        const float a8 = 8.0f * dt * P.in[I_LRE][g * 64 + p], b8 = 8.0f * dt * P.in[I_LIM][g * 64 + p];
        float s8, c8; sincosf(b8, &s8, &c8); const float e8 = expf(a8); const float Ar = e8 * c8, Ai = e8 * s8;
        bf16x8 Ef[4], B3f[8];
        { const bf16* Eg = E + (size_t)g * 128 * 128 + (size_t)(16 * wid + fr) * 128 + 8 * fq;
#pragma unroll
          for (int kk = 0; kk < 4; ++kk) Ef[kk] = *(const bf16x8*)(Eg + 32 * kk);
          const bf16* Bg = B3 + (size_t)g * 128 * 256 + (size_t)(16 * wid + fr) * 256 + 8 * fq;
#pragma unroll
          for (int kk = 0; kk < 8; ++kk) B3f[kk] = *(const bf16x8*)(Bg + 32 * kk); }
        float cr = 0.f, ci = 0.f;
        for (int blk = 0; blk < 5; ++blk) {
            const int nmb = blk < 4 ? 4 : 1;
            const int tok0 = blk < 4 ? b * SEQ + blk * 512 : MP + 128 * b;
            const bf16* Ab = UG + ((size_t)g * MTOT + tok0) * 16;
            bf16x8 Af[4][4];
#pragma unroll
            for (int mb = 0; mb < 4; ++mb)
#pragma unroll
                for (int kk = 0; kk < 4; ++kk) { if (mb < nmb) Af[mb][kk] = *(const bf16x8*)(Ab + (size_t)(16 * mb + fr) * 128 + 32 * kk + 8 * fq); else Af[mb][kk] = (bf16x8){0, 0, 0, 0, 0, 0, 0, 0}; }
#pragma unroll
            for (int mb = 0; mb < 4; ++mb) if (mb < nmb) { f32x4 acc = (f32x4){0.f, 0.f, 0.f, 0.f};
#pragma unroll
                for (int kk = 0; kk < 4; ++kk) acc = __builtin_amdgcn_mfma_f32_16x16x32_bf16(Ef[kk], Af[mb][kk], acc, 0, 0, 0);
                *(LAS f32x4*)(Hl + (16 * mb + fr) * HL_LD + 16 * wid + 4 * fq) = acc; }
            __syncthreads();
            if (blk < 4) {
                if (wid == 0) {
#pragma unroll 8
                    for (int c = 0; c < 64; ++c) { const float hr = Hl[c * HL_LD + p], hi = Hl[c * HL_LD + 64 + p];
                        Hp[c * HP_LD + p] = (bf16)f2bf(cr); Hp[c * HP_LD + 64 + p] = (bf16)f2bf(ci);
                        const float ncr = Ar * cr - Ai * ci + hr, nci = Ar * ci + Ai * cr + hi; cr = ncr; ci = nci; }
                    if (blk == 3) { P.out[O_REP + (size_t)(b * NG + g) * SP + p] = cr; P.out[O_IMP + (size_t)(b * NG + g) * SP + p] = ci; }
                }
            } else {
                for (int c = wid; c < 16; c += NWAVES) { const size_t si = ((size_t)(16 * b + c) * NG + g) * SP + p;
                    const float h0r = P.in[I_SRE][si], h0i = P.in[I_SIM][si];
                    Hp[c * HP_LD + p] = (bf16)f2bf(h0r); Hp[c * HP_LD + 64 + p] = (bf16)f2bf(h0i);
                    P.out[O_RES + si] = Ar * h0r - Ai * h0i + Hl[c * HL_LD + p]; P.out[O_IMS + si] = Ar * h0i + Ai * h0r + Hl[c * HL_LD + 64 + p]; }
            }
            __syncthreads();
#pragma unroll
            for (int mb = 0; mb < 4; ++mb) if (mb < nmb) { f32x4 acc = (f32x4){0.f, 0.f, 0.f, 0.f};
#pragma unroll
                for (int kk = 0; kk < 4; ++kk) acc = __builtin_amdgcn_mfma_f32_16x16x32_bf16(B3f[kk], Af[mb][kk], acc, 0, 0, 0);
#pragma unroll
                for (int kk = 0; kk < 4; ++kk) { const bf16x8 hp = *(const LAS bf16x8*)(Hp + (16 * mb + fr) * HP_LD + 32 * kk + 8 * fq); acc = __builtin_amdgcn_mfma_f32_16x16x32_bf16(B3f[4 + kk], hp, acc, 0, 0, 0); }
                const int tok = tok0 + 8 * (16 * mb + fr) + wid;
                *(v2u*)(Z + (size_t)tok * 512 + 16 * g + 4 * fq) = (v2u){pk2(gelu_tanh(acc[0]), gelu_tanh(acc[1])), pk2(gelu_tanh(acc[2]), gelu_tanh(acc[3]))}; }
            __syncthreads();
        }
    }
}
__device__ __forceinline__ void conv_rows(const Params& P, int cw, int ncw) {
    const int lane = threadIdx.x & 63, ch = 8 * lane;
    unsigned char* ws = P.ws; const bf16* BG = (const bf16*)(ws + WS_BG); const bf16* V = (const bf16*)(ws + WS_V); bf16* MIX = (bf16*)(ws + WS_MIX);
    const float* cwp = P.in[I_CONVW];
    float w0[8], w1[8], w2[8];
#pragma unroll
    for (int i = 0; i < 8; ++i) { w0[i] = cwp[ch + i]; w1[i] = cwp[512 + ch + i]; w2[i] = cwp[1024 + ch + i]; }
    for (int row = cw; row < MTOT; row += ncw) {
        int t, L; const float* past = nullptr; float* cnew;
        if (row < MP) { t = row & (SEQ - 1); L = SEQ; cnew = P.out + O_CONVP + (size_t)(row >> 11) * 2 * WC; }
        else { const int rs = row - MP; t = rs & 7; L = DSEQ; past = P.in[I_CCONV] + (size_t)(rs >> 3) * 2 * WC; cnew = P.out + O_CONVS + (size_t)(rs >> 3) * 2 * WC; }
        float va[8], vb[8], vc[8];
        { const v4u c4 = *(const v4u*)(V + (size_t)row * 512 + ch); vc[0] = pg8::bf_lo(c4.x); vc[1] = pg8::bf_hi(c4.x); vc[2] = pg8::bf_lo(c4.y); vc[3] = pg8::bf_hi(c4.y); vc[4] = pg8::bf_lo(c4.z); vc[5] = pg8::bf_hi(c4.z); vc[6] = pg8::bf_lo(c4.w); vc[7] = pg8::bf_hi(c4.w); }
        if (t >= 1) { const v4u c4 = *(const v4u*)(V + (size_t)(row - 1) * 512 + ch); vb[0] = pg8::bf_lo(c4.x); vb[1] = pg8::bf_hi(c4.x); vb[2] = pg8::bf_lo(c4.y); vb[3] = pg8::bf_hi(c4.y); vb[4] = pg8::bf_lo(c4.z); vb[5] = pg8::bf_hi(c4.z); vb[6] = pg8::bf_lo(c4.w); vb[7] = pg8::bf_hi(c4.w); }
        else {
#pragma unroll
            for (int i = 0; i < 8; ++i) vb[i] = past ? past[WC + ch + i] : 0.f; }
        if (t >= 2) { const v4u c4 = *(const v4u*)(V + (size_t)(row - 2) * 512 + ch); va[0] = pg8::bf_lo(c4.x); va[1] = pg8::bf_hi(c4.x); va[2] = pg8::bf_lo(c4.y); va[3] = pg8::bf_hi(c4.y); va[4] = pg8::bf_lo(c4.z); va[5] = pg8::bf_hi(c4.z); va[6] = pg8::bf_lo(c4.w); va[7] = pg8::bf_hi(c4.w); }
        else {
#pragma unroll
            for (int i = 0; i < 8; ++i) va[i] = past ? past[t * WC + ch + i] : 0.f; }
        const v4u b4 = *(const v4u*)(BG + (size_t)row * 512 + ch);
        float bg[8] = {pg8::bf_lo(b4.x), pg8::bf_hi(b4.x), pg8::bf_lo(b4.y), pg8::bf_hi(b4.y), pg8::bf_lo(b4.z), pg8::bf_hi(b4.z), pg8::bf_lo(b4.w), pg8::bf_hi(b4.w)};
        float o[8];
#pragma unroll
        for (int i = 0; i < 8; ++i) o[i] = bg[i] * (w0[i] * va[i] + w1[i] * vb[i] + w2[i] * vc[i]);
        *(v4u*)(MIX + (size_t)row * 1024 + ch) = (v4u){pk2(o[0], o[1]), pk2(o[2], o[3]), pk2(o[4], o[5]), pk2(o[6], o[7])};
        if (t >= L - 2) { float* d = cnew + (size_t)(t - (L - 2)) * WC + ch; *(f32x4*)d = (f32x4){vc[0], vc[1], vc[2], vc[3]}; *(f32x4*)(d + 4) = (f32x4){vc[4], vc[5], vc[6], vc[7]}; }
    }
}
__device__ __forceinline__ void final_norm(const Params& P, int gw, int NGW) {
    const int lane = threadIdx.x & 63;
    const unsigned long long* SS2 = (const unsigned long long*)(P.ws + WS_SS2);
    const f32x4* gr = (const f32x4*)P.in[I_NFIN] + lane;
    f32x4 gg[4];
#pragma unroll
    for (int j = 0; j < 4; ++j) gg[j] = gr[64 * j];
    for (int m = gw; m < MTOT; m += NGW) { f32x4* xr = (f32x4*)(P.out + (size_t)m * D) + lane;
        const float rstd = 1.0f / sqrtf((float)SS2[m] * (1.0f / (pg8::SS_SCALE * 1024.0f)) + EPS);
#pragma unroll
        for (int j = 0; j < 4; ++j) { f32x4 v = xr[64 * j]; xr[64 * j] = v * rstd * gg[j]; } }
}

__global__ void __launch_bounds__(NTHR, 2) mega_fwd(Params P) {
    extern __shared__ __attribute__((aligned(16))) unsigned char lds_raw[];
    LAS unsigned char* lds = (LAS unsigned char*)lds_raw;
    cg::grid_group grid = cg::this_grid();
    const int G = gridDim.x, bx = blockIdx.x;
    const int vcu = (G % 8 == 0) ? (bx % 8) * (G / 8) + bx / 8 : bx;
    const int wave = __builtin_amdgcn_readfirstlane(threadIdx.x >> 6);
    unsigned char* ws = P.ws;
    bf16* XN = (bf16*)(ws + WS_XN);
    p0_prologue(P, lds, vcu, G);
    grid.sync();
    { pg8::Gemm g{XN, (const bf16*)(ws + WS_WIN), MTOT, NPROJ, D}; pg8::StaticOrder S; S.init(MTOT, NPROJ, G, bx);
      pg8::EpiProj E{(bf16*)(ws + WS_BG), (bf16*)(ws + WS_V), (bf16*)(ws + WS_UG)};
      pg8::gemm_phase<pg8::EpiProj, pg8::StaticOrder, true, true>(lds, g, S, E); }
    grid.sync();
    ssm_phase(P, lds, G);
    grid.sync();
    { pg8::Gemm g{(const bf16*)(ws + WS_Z), (const bf16*)(ws + WS_WGLU), MTOT, 512, 512}; pg8::StaticOrder S; S.init(MTOT, 512, G, bx);
      pg8::EpiGlu E{(const bf16*)(ws + WS_Z), P.in[I_BGLU], (bf16*)(ws + WS_MIX)};
      pg8::gemm_phase<pg8::EpiGlu, pg8::StaticOrder, true, true>(lds, g, S, E);
      const int nglu = (MTOT / 256) * 2, first = (G > nglu) ? nglu : 0;
      if (bx >= first) conv_rows(P, (bx - first) * NWAVES + wave, (G - first) * NWAVES); }
    grid.sync();
    { pg8::Gemm g{(const bf16*)(ws + WS_MIX), (const bf16*)(ws + WS_WOUT), MTOT, D, D}; pg8::StaticOrder S; S.init(MTOT, D, G, bx);
      pg8::EpiRes<true> E{P.in[I_XP], P.in[I_XS], P.out + O_Y, XN, (unsigned long long*)(ws + WS_SS1)};
      pg8::gemm_phase<pg8::EpiRes<true>, pg8::StaticOrder, true, true>(lds, g, S, E); }
    grid.sync();
    { pg8::Gemm g{XN, (const bf16*)(ws + WS_WGU), MTOT, NGU, D}; pg8::StaticOrder S; S.init(MTOT, NGU, G, bx);
      pg8::EpiFfn1 E{(const unsigned long long*)(ws + WS_SS1), (bf16*)(ws + WS_H)};
      pg8::gemm_phase<pg8::EpiFfn1, pg8::StaticOrder, true, true>(lds, g, S, E); }
    grid.sync();
    { pg8::Gemm g{(const bf16*)(ws + WS_H), (const bf16*)(ws + WS_WDN), MTOT, D, DFF}; pg8::StaticOrder S; S.init(MTOT, D, G, bx);
      pg8::EpiRes<false> E{P.out + O_Y, P.out + O_Y + (size_t)MP * D, P.out + O_Y, nullptr, (unsigned long long*)(ws + WS_SS2)};
      pg8::gemm_phase<pg8::EpiRes<false>, pg8::StaticOrder, true, true>(lds, g, S, E); }
    grid.sync();
    final_norm(P, vcu * NWAVES + wave, G * NWAVES);
}

extern "C" void kernel_launch(void* const* d_in, const int* in_sizes, int n_in, void* d_out, int out_size, void* d_ws, size_t ws_size, hipStream_t stream) {
    static int grid = 0;
    if (grid == 0) {
        if (n_in != 24 || in_sizes[0] != MP * D || (size_t)out_size != O_END || ws_size < WS_END) { fprintf(stderr, "kernel_launch: unexpected shapes (n_in %d, in0 %d, out %d, ws %zu); nothing launched\n", n_in, n_in > 0 ? in_sizes[0] : -1, out_size, ws_size); grid = -1; return; }
        int dev = 0, cus = 0, per_cu = 0;
        if (hipGetDevice(&dev) != hipSuccess || hipDeviceGetAttribute(&cus, hipDeviceAttributeMultiprocessorCount, dev) != hipSuccess) { fprintf(stderr, "kernel_launch: device query failed\n"); grid = -1; return; }
        if (hipFuncSetAttribute((const void*)mega_fwd, hipFuncAttributeMaxDynamicSharedMemorySize, LDS_BYTES) != hipSuccess) { fprintf(stderr, "kernel_launch: hipFuncSetAttribute failed\n"); grid = -1; return; }
        if (hipOccupancyMaxActiveBlocksPerMultiprocessor(&per_cu, (const void*)mega_fwd, NTHR, LDS_BYTES) != hipSuccess || per_cu < 1) { fprintf(stderr, "kernel_launch: occupancy query reports %d workgroups per CU\n", per_cu); (void)hipGetLastError(); grid = -1; return; }
        grid = cus * 1;
    }
    if (grid < 0) return;
    Params p{};
    for (int i = 0; i < 24; ++i) p.in[i] = (const float*)d_in[i];
    p.out = (float*)d_out; p.ws = (unsigned char*)d_ws;
    void* args[] = {&p};
    const hipError_t e = hipLaunchCooperativeKernel((const void*)mega_fwd, dim3(grid), dim3(NTHR), args, LDS_BYTES, stream);
    if (e != hipSuccess) fprintf(stderr, "kernel_launch: cooperative launch failed: %s (grid %d)\n", hipGetErrorString(e), grid);
}
```

```cpp
#include <hip/hip_runtime.h>
#include <hip/hip_cooperative_groups.h>
#include <cstdio>
#include <cstdint>
namespace pg8 {
#define PG8_LAS __attribute__((address_space(3)))
typedef unsigned short bf16_t;
typedef short bf16x8 __attribute__((ext_vector_type(8)));
typedef float f32x4 __attribute__((ext_vector_type(4)));
typedef unsigned u32x4 __attribute__((ext_vector_type(4)));
constexpr int BM = 256, BK = 64, HALF = 128, HTB = HALF * BK * 2  , STAGE_BYTES = 8 * HTB, NXCD = 8, WGM = 8;

__host__ __device__ __forceinline__ int lds_byte(int r, int c) { const int st = (r >> 4) * 2 + (c >> 5), rr = r & 15, cc = c & 31, ob = rr * 64 + cc * 2; return st * 1024 + (ob ^ (((ob >> 9) & 1) << 5)); }
__host__ __device__ __forceinline__ void stage_rc(int b, int& R, int& C) { const int st = b / 1024, sb = b % 1024, swz = sb ^ (((sb >> 9) & 1) << 5); R = (st >> 1) * 16 + swz / 64; C = (st & 1) * 32 + (swz % 64) / 2; }
__host__ __device__ __forceinline__ int perm32(int rho) { const int n = rho >> 4, i = rho & 15; return 8 * (i >> 2) + 4 * n + (i & 3); }

struct Unit { int pm, pn; };
struct Gemm { const bf16_t* A; const bf16_t* Bt; int M, N, K; };

struct StaticOrder {
    int nM, nN, nwg, G, c;
    __host__ __device__ void init(int M, int N, int G_, int c_) { nM = M / BM; nN = N / BM; nwg = nM * nN; G = G_; c = c_; }
    __host__ __device__ bool next(int i, Unit& u) const {
        const long L = (long)i * G + c; if (L >= nwg) return false;
        int wgid = (int)L; { const int q = nwg / NXCD, r = nwg % NXCD, xcd = wgid % NXCD, off = wgid / NXCD; wgid = (xcd < r ? xcd * (q + 1) : r * (q + 1) + (xcd - r) * q) + off; }
        const int nig = WGM * nN, gid = wgid / nig, fm = gid * WGM, gsz = (nM - fm) < WGM ? (nM - fm) : WGM;
        u.pm = fm + ((wgid % nig) % gsz); u.pn = (wgid % nig) / gsz; return true;
    }
    __device__ __forceinline__ void a_ready(const Unit&) const {}
    __device__ __forceinline__ void done(const Unit&) const {}
};

__device__ __forceinline__ unsigned cvt_pk_bf16(float lo, float hi) { unsigned r; asm volatile("v_cvt_pk_bf16_f32 %0, %1, %2" : "=v"(r) : "v"(lo), "v"(hi)); return r; }
typedef float f32x2 __attribute__((ext_vector_type(2)));
constexpr int MTOT = 17408;
__device__ __forceinline__ float bf_lo(unsigned w) { return __uint_as_float(w << 16); }
__device__ __forceinline__ float bf_hi(unsigned w) { return __uint_as_float(w & 0xffff0000u); }
__device__ __forceinline__ float sigmoidf_fast(float a) { return __builtin_amdgcn_rcpf(1.0f + __expf(-a)); }
__device__ __forceinline__ u32x4 pack8(const f32x4 v0, const f32x4 v1) { u32x4 w; w.x = cvt_pk_bf16(v0[0], v0[1]); w.y = cvt_pk_bf16(v0[2], v0[3]); w.z = cvt_pk_bf16(v1[0], v1[1]); w.w = cvt_pk_bf16(v1[2], v1[3]); return w; }

struct EpiProj {
    static constexpr bool PERM = true, AFTER_DRAIN = false;
    bf16_t* BG; bf16_t* V; bf16_t* UG;
    __device__ __forceinline__ void operator()(const f32x4 (&acc)[2][2][4][2], const Unit& u, int wr, int wc, int fr, int fq) const {
        const int row0 = u.pm * BM + wr * 64 + fr, pn = u.pn;
        if (pn >= 2 && pn < 6) {
            const int col = 128 * (pn - 2) + 32 * wc + 8 * fq;
#pragma unroll
            for (int ai = 0; ai < 2; ++ai)
#pragma unroll
                for (int m = 0; m < 4; ++m) { const int row = row0 + ai * HALF + m * 16;
                    const f32x4 v0 = acc[ai][0][m][0] * acc[ai][1][m][0], v1 = acc[ai][0][m][1] * acc[ai][1][m][1];
                    *(u32x4*)(V + (size_t)row * 512 + col) = pack8(v0, v1); }
        } else if (pn < 2) {
#pragma unroll
            for (int ai = 0; ai < 2; ++ai)
#pragma unroll
                for (int m = 0; m < 4; ++m) { const int row = row0 + ai * HALF + m * 16;
#pragma unroll
                    for (int bj = 0; bj < 2; ++bj) *(u32x4*)(BG + (size_t)row * 512 + 256 * pn + 128 * bj + 32 * wc + 8 * fq) = pack8(acc[ai][bj][m][0], acc[ai][bj][m][1]); }
        } else {
#pragma unroll
            for (int ai = 0; ai < 2; ++ai)
#pragma unroll
                for (int m = 0; m < 4; ++m) { const int row = row0 + ai * HALF + m * 16;
#pragma unroll
                    for (int bj = 0; bj < 2; ++bj) { const int cu = 256 * (pn - 6) + 128 * bj + 32 * wc + 8 * fq;
                        *(u32x4*)(UG + ((size_t)(cu >> 4) * MTOT + row) * 16 + (cu & 15)) = pack8(acc[ai][bj][m][0], acc[ai][bj][m][1]); } }
        }
    }
};
struct EpiGlu {
    static constexpr bool PERM = true, AFTER_DRAIN = false;
    const bf16_t* Z; const float* bias; bf16_t* MIX;
    __device__ __forceinline__ void operator()(const f32x4 (&acc)[2][2][4][2], const Unit& u, int wr, int wc, int fr, int fq) const {
        const int row0 = u.pm * BM + wr * 64 + fr;
#pragma unroll
        for (int bj = 0; bj < 2; ++bj) { const int col = 256 * u.pn + 128 * bj + 32 * wc + 8 * fq;
            const f32x4 b0 = *(const f32x4*)(bias + col), b1 = *(const f32x4*)(bias + col + 4);
#pragma unroll
            for (int ai = 0; ai < 2; ++ai)
#pragma unroll
                for (int m = 0; m < 4; ++m) { const int row = row0 + ai * HALF + m * 16;
                    const u32x4 zz = *(const u32x4*)(Z + (size_t)row * 512 + col);
                    const f32x4 a0 = acc[ai][bj][m][0] + b0, a1 = acc[ai][bj][m][1] + b1;
                    f32x4 o0, o1;
                    o0[0] = bf_lo(zz.x) * sigmoidf_fast(a0[0]); o0[1] = bf_hi(zz.x) * sigmoidf_fast(a0[1]); o0[2] = bf_lo(zz.y) * sigmoidf_fast(a0[2]); o0[3] = bf_hi(zz.y) * sigmoidf_fast(a0[3]);
                    o1[0] = bf_lo(zz.z) * sigmoidf_fast(a1[0]); o1[1] = bf_hi(zz.z) * sigmoidf_fast(a1[1]); o1[2] = bf_lo(zz.w) * sigmoidf_fast(a1[2]); o1[3] = bf_hi(zz.w) * sigmoidf_fast(a1[3]);
                    *(u32x4*)(MIX + (size_t)row * 1024 + 512 + col) = pack8(o0, o1); } }
    }
};
constexpr float SS_SCALE = 16777216.0f;
template <bool WITH_BF16> struct EpiRes {
    static constexpr bool PERM = true, AFTER_DRAIN = false;
    const float* xp; const float* xs; float* xo; bf16_t* xb; unsigned long long* SS;
    __device__ __forceinline__ void operator()(const f32x4 (&acc)[2][2][4][2], const Unit& u, int wr, int wc, int fr, int fq) const {
        const int row0 = u.pm * BM + wr * 64 + fr;
        const float* xi = (u.pm < 64) ? xp : xs - (size_t)16384 * 1024;
#pragma unroll
        for (int ai = 0; ai < 2; ++ai)
#pragma unroll
            for (int m = 0; m < 4; ++m) { const int row = row0 + ai * HALF + m * 16; float ss = 0.f;
#pragma unroll
                for (int bj = 0; bj < 2; ++bj) { const size_t off = (size_t)row * 1024 + 256 * u.pn + 128 * bj + 32 * wc + 8 * fq;
                    const f32x4 v0 = *(const f32x4*)(xi + off) + acc[ai][bj][m][0], v1 = *(const f32x4*)(xi + off + 4) + acc[ai][bj][m][1];
                    ss += (v0[0] * v0[0] + v0[1] * v0[1]) + (v0[2] * v0[2] + v0[3] * v0[3]) + (v1[0] * v1[0] + v1[1] * v1[1]) + (v1[2] * v1[2] + v1[3] * v1[3]);
                    *(f32x4*)(xo + off) = v0; *(f32x4*)(xo + off + 4) = v1;
                    if (WITH_BF16) *(u32x4*)(xb + off) = pack8(v0, v1); }
                ss += __shfl_xor(ss, 16); ss += __shfl_xor(ss, 32);
                if (fq == 0) atomicAdd(SS + row, (unsigned long long)(ss * SS_SCALE + 0.5f)); }
    }
};
struct EpiFfn1 {
    static constexpr bool PERM = true, AFTER_DRAIN = false;
    const unsigned long long* SS; bf16_t* H;
    __device__ __forceinline__ void operator()(const f32x4 (&acc)[2][2][4][2], const Unit& u, int wr, int wc, int fr, int fq) const {
        const int row0 = u.pm * BM + wr * 64 + fr, col = 128 * u.pn + 32 * wc + 8 * fq;
#pragma unroll
        for (int ai = 0; ai < 2; ++ai)
#pragma unroll
            for (int m = 0; m < 4; ++m) { const int row = row0 + ai * HALF + m * 16;
                const float rs = __builtin_amdgcn_rsqf((float)SS[row] * (1.0f / (SS_SCALE * 1024.0f)) + 1e-5f);
                f32x4 o[2];
#pragma unroll
                for (int n = 0; n < 2; ++n)
#pragma unroll
                    for (int i = 0; i < 4; ++i) { const float g = acc[ai][0][m][n][i] * rs, uu = acc[ai][1][m][n][i] * rs; o[n][i] = g * sigmoidf_fast(g) * uu; }
                *(u32x4*)(H + (size_t)row * 2816 + col) = pack8(o[0], o[1]); }
    }
};
template <class Epi, class Sched, bool ALIGN_EPI = false, bool SP2 = false>
__device__ __forceinline__ void gemm_phase(PG8_LAS unsigned char* lds, const Gemm g, const Sched& S, const Epi& E) {
    const int tid = threadIdx.x, wid = __builtin_amdgcn_readfirstlane(tid >> 6), lane = tid & 63, wr = wid >> 2, wc = wid & 3, fr = lane & 15, fq = lane >> 4;
    const int K = g.K, nt = K / BK;
    unsigned voffA[2], voffB[2];
#pragma unroll
    for (int i = 0; i < 2; ++i) { int R, C; stage_rc(tid * 16 + i * 8192, R, C); const int Rb = Epi::PERM ? ((R & ~31) + perm32(R & 31)) : R;
        voffA[i] = (unsigned)(R * K + C) * 2u; voffB[i] = (unsigned)(Rb * K + C) * 2u; }
    const size_t kstep = (size_t)(BK * 2);
    const size_t hstep = (size_t)HALF * K * 2;
    const size_t tstep = 2 * hstep;
    const unsigned ldsw = (unsigned)wid * 1024u;
    const int aoff = lds_byte(wr * 64 + fr, fq * 8), boff = lds_byte(wc * 32 + fr, fq * 8);
#define PG8_SA(b, h) (((b) * 2 + (h)) * HTB)
#define PG8_SB(b, h) ((4 + (b) * 2 + (h)) * HTB)
#define PG8_STAGE(bufoff, gbase, voff) do { _Pragma("unroll") for (int _i = 0; _i < 2; ++_i) \
        __builtin_amdgcn_global_load_lds((const unsigned*)((const char*)(gbase) + (voff)[_i]), (PG8_LAS unsigned*)(lds + (bufoff) + ldsw + _i * 8192), 16, 0, 0); } while (0)
#define PG8_LDA(dst, b, h) do { _Pragma("unroll") for (int m = 0; m < 4; ++m) _Pragma("unroll") for (int k = 0; k < 2; ++k) dst[m][k] = *(const PG8_LAS bf16x8*)(lds + PG8_SA(b, h) + aoff + m * 2048 + k * 1024); } while (0)
#define PG8_LDB(dst, b, h) do { _Pragma("unroll") for (int n = 0; n < 2; ++n) _Pragma("unroll") for (int k = 0; k < 2; ++k) dst[n][k] = *(const PG8_LAS bf16x8*)(lds + PG8_SB(b, h) + boff + n * 2048 + k * 1024); } while (0)
#define PG8_MMA(ai, bj, At, Bt) do { __builtin_amdgcn_s_setprio(1); _Pragma("unroll") for (int m = 0; m < 4; ++m) _Pragma("unroll") for (int n = 0; n < 2; ++n) _Pragma("unroll") for (int k = 0; k < 2; ++k) \
        acc[ai][bj][m][n] = __builtin_amdgcn_mfma_f32_16x16x32_bf16(Bt[n][k], At[m][k], acc[ai][bj][m][n], 0, 0, 0); __builtin_amdgcn_s_setprio(0); } while (0)
#define PG8_WAIT_V(n) asm volatile("s_waitcnt vmcnt(" #n ")" ::: "memory")
#define PG8_WAIT_L(n) asm volatile("s_waitcnt lgkmcnt(" #n ")" ::: "memory")
#define PG8_BAR __builtin_amdgcn_s_barrier()
#define PG8_SCHED __builtin_amdgcn_sched_barrier(0)
    Unit cur, nxt; int ui = 0;
    if (!S.next(0, cur)) return;
    f32x4 acc[2][2][4][2];
#pragma unroll
    for (int a = 0; a < 2; ++a)
#pragma unroll
        for (int b = 0; b < 2; ++b)
#pragma unroll
            for (int m = 0; m < 4; ++m)
#pragma unroll
                for (int n = 0; n < 2; ++n) acc[a][b][m][n] = (f32x4){0.f, 0.f, 0.f, 0.f};
    bf16x8 At[4][2], B0[2][2], B1[2][2];
    const char* cA = (const char*)g.A + (size_t)cur.pm * tstep; const char* cB = (const char*)g.Bt + (size_t)cur.pn * tstep;
    S.a_ready(cur);
    if constexpr (SP2) {
        PG8_STAGE(PG8_SB(0, 0), cB, voffB); PG8_STAGE(PG8_SB(0, 1), cB + hstep, voffB); PG8_STAGE(PG8_SA(0, 0), cA, voffA); PG8_STAGE(PG8_SA(0, 1), cA + hstep, voffA);
        if (wr == 1) PG8_BAR;
        PG8_WAIT_V(2); PG8_BAR;
        PG8_STAGE(PG8_SB(1, 0), cB + kstep, voffB); PG8_STAGE(PG8_SA(1, 0), cA + kstep, voffA); PG8_STAGE(PG8_SB(1, 1), cB + hstep + kstep, voffB);
        PG8_WAIT_V(6); PG8_BAR;
    } else {
        PG8_STAGE(PG8_SB(0, 0), cB, voffB); PG8_STAGE(PG8_SA(0, 0), cA, voffA); PG8_STAGE(PG8_SB(0, 1), cB + hstep, voffB); PG8_STAGE(PG8_SA(0, 1), cA + hstep, voffA);
        if (wr == 1) PG8_BAR;
        PG8_WAIT_V(4); PG8_BAR;
        PG8_STAGE(PG8_SB(1, 0), cB + kstep, voffB); PG8_STAGE(PG8_SA(1, 0), cA + kstep, voffA); PG8_STAGE(PG8_SB(1, 1), cB + hstep + kstep, voffB);
        PG8_WAIT_V(6); PG8_BAR;
    }
    for (;;) {
        const bool has_next = S.next(ui + 1, nxt);
        const char* nA = has_next ? (const char*)g.A + (size_t)nxt.pm * tstep : cA; const char* nB = has_next ? (const char*)g.Bt + (size_t)nxt.pn * tstep : cB;
        for (int t = 0; t < nt; t += 2) {
            const bool last = (t == nt - 2);
            const char* a1 = cA + (size_t)(t + 1) * kstep;
            const char* a2 = last ? nA : cA + (size_t)(t + 2) * kstep; const char* b2 = last ? nB : cB + (size_t)(t + 2) * kstep;
            const char* a3 = a2 + kstep; const char* b3 = b2 + kstep;
            if (last && has_next) S.a_ready(nxt);
            if constexpr (SP2) {
            PG8_LDB(B0, 0, 0); PG8_LDB(B1, 0, 1); PG8_SCHED; PG8_LDA(At, 0, 0); PG8_STAGE(PG8_SA(1, 1), a1 + hstep, voffA);
            PG8_WAIT_V(8); PG8_WAIT_L(0); PG8_BAR; PG8_MMA(0, 0, At, B0); PG8_MMA(0, 1, At, B1); PG8_BAR; PG8_SCHED;
            PG8_LDA(At, 0, 1); PG8_STAGE(PG8_SB(0, 0), b2, voffB); PG8_STAGE(PG8_SB(0, 1), b2 + hstep, voffB); PG8_STAGE(PG8_SA(0, 0), a2, voffA);
            PG8_WAIT_V(8); PG8_WAIT_L(0); PG8_BAR; PG8_MMA(1, 0, At, B0); PG8_MMA(1, 1, At, B1); PG8_BAR; PG8_SCHED;
            PG8_LDB(B0, 1, 0); PG8_LDB(B1, 1, 1); PG8_SCHED; PG8_LDA(At, 1, 0); PG8_STAGE(PG8_SA(0, 1), a2 + hstep, voffA);
            PG8_WAIT_V(8); PG8_WAIT_L(0); PG8_BAR; PG8_MMA(0, 0, At, B0); PG8_MMA(0, 1, At, B1); PG8_BAR; PG8_SCHED;
            PG8_LDA(At, 1, 1); PG8_STAGE(PG8_SB(1, 0), b3, voffB); PG8_STAGE(PG8_SB(1, 1), b3 + hstep, voffB); PG8_STAGE(PG8_SA(1, 0), a3, voffA);
            PG8_WAIT_V(8); PG8_WAIT_L(0); PG8_BAR; PG8_MMA(1, 0, At, B0); PG8_MMA(1, 1, At, B1); PG8_BAR; PG8_SCHED;
            } else {
            PG8_LDB(B0, 0, 0); PG8_SCHED; PG8_LDA(At, 0, 0); PG8_STAGE(PG8_SA(1, 1), a1 + hstep, voffA);
            PG8_WAIT_L(8); PG8_BAR; PG8_WAIT_L(0); PG8_MMA(0, 0, At, B0); PG8_BAR; PG8_SCHED;
            PG8_LDB(B1, 0, 1); PG8_STAGE(PG8_SB(0, 0), b2, voffB);
            PG8_BAR; PG8_WAIT_L(0); PG8_MMA(0, 1, At, B1); PG8_BAR;
            PG8_LDA(At, 0, 1); PG8_STAGE(PG8_SA(0, 0), a2, voffA);
            PG8_BAR; PG8_WAIT_L(0); PG8_MMA(1, 0, At, B0); PG8_BAR; PG8_SCHED;
            PG8_STAGE(PG8_SB(0, 1), b2 + hstep, voffB);
            PG8_WAIT_V(6); PG8_BAR; PG8_MMA(1, 1, At, B1); PG8_BAR;
            PG8_LDB(B0, 1, 0); PG8_SCHED; PG8_LDA(At, 1, 0); PG8_STAGE(PG8_SA(0, 1), a2 + hstep, voffA);
            PG8_WAIT_L(8); PG8_BAR; PG8_WAIT_L(0); PG8_MMA(0, 0, At, B0); PG8_BAR; PG8_SCHED;
            PG8_LDB(B1, 1, 1); PG8_STAGE(PG8_SB(1, 0), b3, voffB);
            PG8_BAR; PG8_WAIT_L(0); PG8_MMA(0, 1, At, B1); PG8_BAR;
            PG8_LDA(At, 1, 1); PG8_STAGE(PG8_SA(1, 0), a3, voffA);
            PG8_BAR; PG8_WAIT_L(0); PG8_MMA(1, 0, At, B0); PG8_BAR; PG8_SCHED;
            PG8_STAGE(PG8_SB(1, 1), b3 + hstep, voffB);
            PG8_WAIT_V(6); PG8_BAR; PG8_MMA(1, 1, At, B1); PG8_BAR;
            }
        }
        if constexpr (ALIGN_EPI) { if (wr == 0) PG8_BAR; }
        if constexpr (!Epi::AFTER_DRAIN) { E(acc, cur, wr, wc, fr, fq); S.done(cur); }
        if (!has_next) break;
#pragma unroll
        for (int a = 0; a < 2; ++a)
#pragma unroll
            for (int b = 0; b < 2; ++b)
#pragma unroll
                for (int m = 0; m < 4; ++m)
#pragma unroll
                    for (int n = 0; n < 2; ++n) acc[a][b][m][n] = (f32x4){0.f, 0.f, 0.f, 0.f};
        cur = nxt; cA = nA; cB = nB; ++ui;
        if constexpr (ALIGN_EPI) { if (wr == 1) PG8_BAR; }
    }
    PG8_WAIT_V(0);
    if constexpr (!ALIGN_EPI) { if (wr == 0) PG8_BAR; }
    PG8_BAR;
    if constexpr (Epi::AFTER_DRAIN) { E.fused(acc, cur, wr, wc, fr, fq, lds, wid, lane); S.done(cur); }
#undef PG8_SA
#undef PG8_SB
#undef PG8_STAGE
#undef PG8_LDA
#undef PG8_LDB
#undef PG8_MMA
#undef PG8_WAIT_V
#undef PG8_WAIT_L
#undef PG8_BAR
#undef PG8_SCHED
}
}
namespace cg = cooperative_groups;
#define LAS __attribute__((address_space(3)))
typedef unsigned short bf16;
typedef unsigned v4u __attribute__((ext_vector_type(4)));
typedef unsigned v2u __attribute__((ext_vector_type(2)));
typedef float f32x4 __attribute__((ext_vector_type(4)));
typedef short bf16x8 __attribute__((ext_vector_type(8)));
constexpr int NWAVES = 8, NTHR = 512;
constexpr int D = 1024, MP = 16384, MS = 1024, MTOT = MP + MS, SEQ = 2048, DSEQ = 8, NB = 8, NDB = 128;
constexpr int WC = 512, WS_ = 512, NG = 32, SP = 64, SH = 16, DFF = 2816, NPROJ = 2048, NGU = 2 * DFF;
constexpr float EPS = 1e-5f;
constexpr size_t MiB = 1u << 20;
constexpr size_t WS_SS1 = 0, WS_SS2 = 256 * 1024, WS_BAR = 512 * 1024, CTL_ZERO_BYTES = 1u << 20;
constexpr size_t WS_WIN = 1 * MiB, WS_WGLU = 5 * MiB, WS_WOUT = 6 * MiB, WS_WGU = 8 * MiB, WS_WDN = 19 * MiB + 512 * 1024;
constexpr size_t WS_E = 25 * MiB, WS_B3 = 26 * MiB;
constexpr size_t WS_XN = 28 * MiB;
constexpr size_t WS_BG = 62 * MiB, WS_V = 79 * MiB, WS_UG = 96 * MiB, WS_Z = 113 * MiB, WS_MIX = 130 * MiB;
constexpr size_t WS_H = 62 * MiB;
constexpr size_t WS_END = 164 * MiB;
static_assert(WS_WGU + (size_t)NGU * D * 2 <= WS_WDN && WS_WDN + (size_t)D * DFF * 2 <= WS_E && WS_B3 + (size_t)NG * 128 * 256 * 2 <= WS_XN, "ws map");
static_assert(WS_XN + (size_t)MTOT * D * 2 <= WS_BG && WS_BG + (size_t)MTOT * 512 * 2 <= WS_V && WS_MIX + (size_t)MTOT * D * 2 <= WS_END && WS_H + (size_t)MTOT * DFF * 2 <= WS_END, "ws map");
constexpr size_t O_Y = 0, O_CONVP = (size_t)MTOT * D, O_REP = O_CONVP + 8192, O_IMP = O_REP + 16384, O_CONVS = O_IMP + 16384, O_RES = O_CONVS + 131072, O_IMS = O_RES + 262144, O_END = O_IMS + 262144;
constexpr int LDS_BYTES = 147456;

struct Params { const float* in[24]; float* out; unsigned char* ws; };
enum { I_XP = 0, I_XS, I_CCONV, I_SRE, I_SIM, I_NMIX, I_WIN, I_CONVW, I_LRE, I_LIM, I_LDT, I_BRE, I_BIM, I_CRE, I_CIM, I_DSK, I_WGLU, I_BGLU, I_WOUT, I_NFFN, I_WGATE, I_WUP, I_WDN, I_NFIN };

__device__ __forceinline__ unsigned f2bf(float f) { unsigned u = __builtin_bit_cast(unsigned, f); return (u + 0x7fffu + ((u >> 16) & 1u)) >> 16; }
__device__ __forceinline__ unsigned pk2(float lo, float hi) { return f2bf(lo) | (f2bf(hi) << 16); }
__device__ __forceinline__ float wave_sum(float v) {
#pragma unroll
    for (int o = 1; o < 64; o <<= 1) v += __shfl_xor(v, o);
    return v;
}
#define LDS_WAIT() asm volatile("s_waitcnt lgkmcnt(0)" ::: "memory")
#define XB_TMO      128
#define XB_XCNT(j)  (256  + 64 * (j))
#define XB_XSUB(j)  (1280 + 64 * (j))
#define XB_XGEN(j)  (2304 + 64 * (j))
#define XB_TOP      3328
#define XB_TOPGEN   3392
#define XCD_BAR_WORDS 3456
#define XB_SPIN_CAP (1u << 18)

__device__ __forceinline__ unsigned xb_ld(unsigned* p)              { return __hip_atomic_load(p, __ATOMIC_RELAXED, __HIP_MEMORY_SCOPE_AGENT); }
__device__ __forceinline__ unsigned xb_add(unsigned* p, unsigned v) { return __hip_atomic_fetch_add(p, v, __ATOMIC_RELAXED, __HIP_MEMORY_SCOPE_AGENT); }
__device__ __forceinline__ unsigned xb_xcc_id() { return (unsigned)__builtin_amdgcn_s_getreg((3 << 11) | 20) & 0xFu; }
#define XB_SPIN(cond, bar) do { unsigned _sp = 0; while (cond) { __builtin_amdgcn_s_sleep(1); \
    if ((++_sp & 255u) == 0u) { if (xb_ld(&(bar)[XB_TMO])) break; if (_sp > XB_SPIN_CAP) { atomicAdd(&(bar)[XB_TMO], 1u); break; } } } } while (0)

struct XcdBarrier {
    unsigned* bar; unsigned x;
    volatile LAS unsigned* st;
};

__device__ __forceinline__ XcdBarrier xcd_barrier_post(unsigned* bar, volatile LAS unsigned* st) {
    XcdBarrier b; b.bar = bar; b.x = xb_xcc_id(); b.st = st;
    if (threadIdx.x == 0) (void)xb_add(&bar[XB_XCNT(b.x)], 1u);
    return b;
}
__device__ __forceinline__ void xcd_barrier_complete(unsigned* bar, unsigned x, unsigned& nloc, unsigned& nx) {
    const unsigned G = gridDim.x * gridDim.y * gridDim.z;
    unsigned sum, cnt, mine, sp = 0u;
    for (;;) {
        sum = 0u; cnt = 0u; mine = 0u;
#pragma unroll
        for (unsigned j = 0; j < 16; ++j) { const unsigned c = xb_ld(&bar[XB_XCNT(j)]); sum += c; cnt += (c > 0u) ? 1u : 0u; mine = (j == x) ? c : mine; }
        if (sum == G) break;
        __builtin_amdgcn_s_sleep(1);
        if ((++sp & 255u) == 0u) { if (xb_ld(&bar[XB_TMO])) break; if (sp > XB_SPIN_CAP) { atomicAdd(&bar[XB_TMO], 1u); break; } }
    }
    nloc = mine > 0u ? mine : 1u; nx = cnt > 0u ? cnt : 1u;
}

__device__ __forceinline__ void xcd_barrier(const XcdBarrier& b) {
    asm volatile("s_waitcnt vmcnt(0)" ::: "memory");
    __syncthreads();
    if (threadIdx.x == 0) {
        unsigned* bar = b.bar;
        __builtin_amdgcn_s_waitcnt(0);
        unsigned nloc = b.st[0], nx = b.st[1];
        if (nloc == 0u) { xcd_barrier_complete(bar, b.x, nloc, nx); b.st[0] = nloc; b.st[1] = nx; }
        const unsigned old = xb_add(&bar[XB_XSUB(b.x)], 1u);
        const unsigned gen = old / nloc;
        if (old + 1u == (gen + 1u) * nloc) {
            __builtin_amdgcn_fence(__ATOMIC_RELEASE, "agent");
            asm volatile("s_waitcnt vmcnt(0)" ::: "memory");
            const unsigned og = xb_add(&bar[XB_TOP], 1u);
            const unsigned tg = og / nx;
            if (og + 1u == (tg + 1u) * nx) xb_add(&bar[XB_TOPGEN], 1u);
            else XB_SPIN(xb_ld(&bar[XB_TOPGEN]) == tg, bar);
            __builtin_amdgcn_fence(__ATOMIC_ACQUIRE, "agent");
            xb_add(&bar[XB_XGEN(b.x)], 1u);
            asm volatile("s_waitcnt vmcnt(0)" ::: "memory");
        } else {
            XB_SPIN(xb_ld(&bar[XB_XGEN(b.x)]) == gen, bar);
            __builtin_amdgcn_fence(__ATOMIC_ACQUIRE, "agent");
            asm volatile("s_waitcnt vmcnt(0)" ::: "memory");
        }
    }
    __syncthreads();
}


__device__ __forceinline__ void transpose_item(const float* W, int N, int K, int k0, int srccol0, bf16* WT, int dstrow0, const float* ksc, LAS float* scr, int lane) {
#pragma unroll 8
    for (int i = 0; i < 32; ++i) { const int kk = 2 * i + (lane >> 5); float v = W[(size_t)(k0 + kk) * N + srccol0 + (lane & 31)]; if (ksc) v *= ksc[k0 + kk]; scr[kk * 33 + (lane & 31)] = v; }
    LDS_WAIT(); asm volatile("" ::: "memory");
    const int c = lane & 7;
#pragma unroll
    for (int j = 0; j < 4; ++j) { const int n = (lane >> 3) + 8 * j; const LAS float* s = scr + (8 * c) * 33 + n;
        v4u o; o.x = pk2(s[0 * 33], s[1 * 33]); o.y = pk2(s[2 * 33], s[3 * 33]); o.z = pk2(s[4 * 33], s[5 * 33]); o.w = pk2(s[6 * 33], s[7 * 33]);
        *(v4u*)(WT + (size_t)(dstrow0 + n) * K + k0 + 8 * c) = o; }
    LDS_WAIT(); asm volatile("" ::: "memory");
}
__device__ __forceinline__ void ssm_mats_item(const Params& P, int g, int tau, bf16* E, bf16* B3, LAS float* scr, int lane) {
    const int p = lane;
    const float dt = expf(P.in[I_LDT][g]);
    const float lr = P.in[I_LRE][g * 64 + p], li = P.in[I_LIM][g * 64 + p];
    const float a = lr * dt, bb = li * dt;
    float sb, cb; sincosf(bb, &sb, &cb);
    const float ea = expf(a), em1 = expm1f(a), sh = sinf(0.5f * bb);
    const float nr = em1 * cb - 2.0f * sh * sh, ni = ea * sb;
    const float den = lr * lr + li * li;
    const float cr = (nr * lr + ni * li) / den, ci = (ni * lr - nr * li) / den;
    float st, ct; sincosf(bb * (float)tau, &st, &ct); const float et = expf(a * (float)tau);
    const float pr = et * ct, pi = et * st;
    const float wr = pr * cr - pi * ci, wi = pr * ci + pi * cr;
    bf16* Eg = E + (size_t)g * 128 * 128; bf16* Bg = B3 + (size_t)g * 128 * 256;
    {
        unsigned er[8], ei[8]; float pw_r = 0.f, pw_i = 0.f;
#pragma unroll
        for (int h = 0; h < 16; ++h) { const float br = P.in[I_BRE][(size_t)(g * 64 + p) * 16 + h], bi = P.in[I_BIM][(size_t)(g * 64 + p) * 16 + h];
            const float Wr = wr * br - wi * bi, Wi = wr * bi + wi * br;
            scr[(h * 64 + p) * 2 + 0] = Wr; scr[(h * 64 + p) * 2 + 1] = Wi;
            if (h & 1) { er[h >> 1] = pk2(pw_r, Wr); ei[h >> 1] = pk2(pw_i, Wi); } else { pw_r = Wr; pw_i = Wi; } }
        v4u* dr = (v4u*)(Eg + (size_t)p * 128 + 16 * (7 - tau)); v4u* di = (v4u*)(Eg + (size_t)(64 + p) * 128 + 16 * (7 - tau));
        dr[0] = (v4u){er[0], er[1], er[2], er[3]}; dr[1] = (v4u){er[4], er[5], er[6], er[7]};
        di[0] = (v4u){ei[0], ei[1], ei[2], ei[3]}; di[1] = (v4u){ei[4], ei[5], ei[6], ei[7]};
    }
    {
        float s1, c1; sincosf(bb * (float)(tau + 1), &s1, &c1); const float e1 = expf(a * (float)(tau + 1));
        const float qr = e1 * c1, qi = e1 * s1;
#pragma unroll 4
        for (int h = 0; h < 16; ++h) { const float Cr = P.in[I_CRE][(size_t)(g * 16 + h) * 64 + p], Ci = P.in[I_CIM][(size_t)(g * 16 + h) * 64 + p];
            Bg[(size_t)(16 * tau + h) * 256 + 128 + p] = (bf16)f2bf(Cr * qr - Ci * qi);
            Bg[(size_t)(16 * tau + h) * 256 + 192 + p] = (bf16)f2bf(-(Cr * qi + Ci * qr)); }
    }
    LDS_WAIT(); asm volatile("" ::: "memory");
    {
        const int h = lane >> 2, hq = 4 * (lane & 3);
        float k0 = 0.f, k1 = 0.f, k2 = 0.f, k3 = 0.f;
        const float* cre = P.in[I_CRE] + (size_t)(g * 16 + h) * 64; const float* cim = P.in[I_CIM] + (size_t)(g * 16 + h) * 64;
#pragma unroll 8
        for (int q = 0; q < 64; ++q) { const float Cr = cre[q], Ci = cim[q]; const LAS float* w = scr + (hq * 64 + q) * 2;
            k0 += Cr * w[0] - Ci * w[1]; k1 += Cr * w[128] - Ci * w[129]; k2 += Cr * w[256] - Ci * w[257]; k3 += Cr * w[384] - Ci * w[385]; }
        if (tau == 0) { const float dsk = P.in[I_DSK][g * 16 + h]; if (hq == (h & ~3)) { const int j = h & 3; if (j == 0) k0 += dsk; else if (j == 1) k1 += dsk; else if (j == 2) k2 += dsk; else k3 += dsk; } }
        const v2u kv = (v2u){pk2(k0, k1), pk2(k2, k3)}, zv = (v2u){0u, 0u};
        for (int t = tau; t < 8; ++t) *(v2u*)(Bg + (size_t)(16 * t + h) * 256 + 16 * (t - tau) + hq) = kv;
        if (tau >= 1) for (int t = 0; t + tau < 8; ++t) *(v2u*)(Bg + (size_t)(16 * t + h) * 256 + 16 * (t + tau) + hq) = zv;
    }
    LDS_WAIT(); asm volatile("" ::: "memory");
}
__device__ __forceinline__ void rms_row_to_bf16(const float* xrow, const float* gw, bf16* orow, int lane) {
    const f32x4* xr = (const f32x4*)xrow + lane; const f32x4* gr = (const f32x4*)gw + lane;
    f32x4 v[4]; float s = 0.f;
#pragma unroll
    for (int j = 0; j < 4; ++j) { v[j] = xr[64 * j]; s += (v[j].x * v[j].x + v[j].y * v[j].y) + (v[j].z * v[j].z + v[j].w * v[j].w); }
    const float rstd = 1.0f / sqrtf(wave_sum(s) * (1.f / D) + EPS);
    unsigned long long* o8 = (unsigned long long*)orow + lane;
#pragma unroll
    for (int j = 0; j < 4; ++j) { const f32x4 gg = gr[64 * j]; o8[64 * j] = (unsigned long long)pk2(v[j].x * rstd * gg.x, v[j].y * rstd * gg.y) | ((unsigned long long)pk2(v[j].z * rstd * gg.z, v[j].w * rstd * gg.w) << 32); }
}
__device__ __forceinline__ void p0_prologue(const Params& P, LAS unsigned char* lds, int vcu, int G) {
    const int tid = threadIdx.x, lane = tid & 63, wave = __builtin_amdgcn_readfirstlane(tid >> 6);
    LAS float* scr = (LAS float*)(lds + wave * 16384);
    const int gw = vcu * NWAVES + wave, NGW = G * NWAVES;
    unsigned char* ws = P.ws;
    constexpr int I_IN = (D / 64) * (NPROJ / 32), I_GLU = (512 / 64) * (512 / 32), I_OUT = (D / 64) * (D / 32), I_GU = (D / 64) * (NGU / 32), I_DN = (DFF / 64) * (D / 32), I_SSM = NG * 8;
    constexpr int NITEMS = I_SSM + I_IN + I_GLU + I_OUT + I_GU + I_DN;
    for (int it = gw; it < NITEMS; it += NGW) {
        int r = it;
        if (r < I_SSM) { ssm_mats_item(P, r >> 3, r & 7, (bf16*)(ws + WS_E), (bf16*)(ws + WS_B3), scr, lane); continue; } r -= I_SSM;
        if (r < I_IN) { const int nblk = NPROJ / 32, kb = r / nblk, nb = r % nblk, n0 = 32 * nb; int src = n0;
            if (n0 >= 512 && n0 < 1536) { const int j = (n0 - 512) >> 8, w = (n0 - 512) & 255; src = (w < 128) ? 512 + 128 * j + w : 1024 + 128 * j + (w - 128); }
            transpose_item(P.in[I_WIN], NPROJ, D, 64 * kb, src, (bf16*)(ws + WS_WIN), n0, nullptr, scr, lane); continue; } r -= I_IN;
        if (r < I_GLU) { const int nblk = 512 / 32, kb = r / nblk, nb = r % nblk; transpose_item(P.in[I_WGLU], 512, 512, 64 * kb, 32 * nb, (bf16*)(ws + WS_WGLU), 32 * nb, nullptr, scr, lane); continue; } r -= I_GLU;
        if (r < I_OUT) { const int nblk = D / 32, kb = r / nblk, nb = r % nblk; transpose_item(P.in[I_WOUT], D, D, 64 * kb, 32 * nb, (bf16*)(ws + WS_WOUT), 32 * nb, nullptr, scr, lane); continue; } r -= I_OUT;
        if (r < I_GU) { const int nblk = NGU / 32, kb = r / nblk, nb = r % nblk, n0 = 32 * nb, j = n0 >> 8, w = n0 & 255;
            const float* src = (w < 128) ? P.in[I_WGATE] : P.in[I_WUP]; const int sc = 128 * j + (w & 127);
            transpose_item(src, DFF, D, 64 * kb, sc, (bf16*)(ws + WS_WGU), n0, P.in[I_NFFN], scr, lane); continue; } r -= I_GU;
        { const int nblk = D / 32, kb = r / nblk, nb = r % nblk; transpose_item(P.in[I_WDN], D, DFF, 64 * kb, 32 * nb, (bf16*)(ws + WS_WDN), 32 * nb, nullptr, scr, lane); }
    }
    bf16* XN = (bf16*)(ws + WS_XN);
    for (int m = gw; m < MTOT; m += NGW) { const float* xr = (m < MP) ? P.in[I_XP] + (size_t)m * D : P.in[I_XS] + (size_t)(m - MP) * D; rms_row_to_bf16(xr, P.in[I_NMIX], XN + (size_t)m * D, lane); }
}

constexpr int HL_LD = 132, HP_LD = 136;
__device__ __forceinline__ float gelu_tanh(float y) { const float t = 1.5957691216057308f * (y + 0.044715f * y * y * y); return y * __builtin_amdgcn_rcpf(1.0f + __expf(-t)); }
__device__ __forceinline__ void ssm_phase(const Params& P, LAS unsigned char* lds, int G) {
    const int tid = threadIdx.x, lane = tid & 63, wid = __builtin_amdgcn_readfirstlane(tid >> 6), fr = lane & 15, fq = lane >> 4;
    LAS float* Hl = (LAS float*)lds;
    LAS bf16* Hp = (LAS bf16*)(lds + 64 * HL_LD * 4);
    unsigned char* ws = P.ws;
    const bf16* E = (const bf16*)(ws + WS_E); const bf16* B3 = (const bf16*)(ws + WS_B3); const bf16* UG = (const bf16*)(ws + WS_UG); bf16* Z = (bf16*)(ws + WS_Z);
    for (int unit = blockIdx.x; unit < NB * NG; unit += G) {
        const int b = unit >> 5, g = unit & 31, p = lane;
        const float dt = expf(P.in[I_LDT][g]);
        const float a8 = 8.0f * dt * P.in[I_LRE][g * 64 + p], b8 = 8.0f * dt * P.in[I_LIM][g * 64 + p];
        float s8, c8; sincosf(b8, &s8, &c8); const float e8 = expf(a8); const float Ar = e8 * c8, Ai = e8 * s8;
        bf16x8 Ef[4], B3f[8];
        { const bf16* Eg = E + (size_t)g * 128 * 128 + (size_t)(16 * wid + fr) * 128 + 8 * fq;
#pragma unroll
          for (int kk = 0; kk < 4; ++kk) Ef[kk] = *(const bf16x8*)(Eg + 32 * kk);
          const bf16* Bg = B3 + (size_t)g * 128 * 256 + (size_t)(16 * wid + fr) * 256 + 8 * fq;
#pragma unroll
          for (int kk = 0; kk < 8; ++kk) B3f[kk] = *(const bf16x8*)(Bg + 32 * kk); }
        float cr = 0.f, ci = 0.f;
        for (int blk = 0; blk < 5; ++blk) {
            const int nmb = blk < 4 ? 4 : 1;
            const int tok0 = blk < 4 ? b * SEQ + blk * 512 : MP + 128 * b;
            const bf16* Ab = UG + ((size_t)g * MTOT + tok0) * 16;
            bf16x8 Af[4][4];
#pragma unroll
            for (int mb = 0; mb < 4; ++mb)
#pragma unroll
                for (int kk = 0; kk < 4; ++kk) { if (mb < nmb) Af[mb][kk] = *(const bf16x8*)(Ab + (size_t)(16 * mb + fr) * 128 + 32 * kk + 8 * fq); else Af[mb][kk] = (bf16x8){0, 0, 0, 0, 0, 0, 0, 0}; }
#pragma unroll
            for (int mb = 0; mb < 4; ++mb) if (mb < nmb) { f32x4 acc = (f32x4){0.f, 0.f, 0.f, 0.f};
#pragma unroll
                for (int kk = 0; kk < 4; ++kk) acc = __builtin_amdgcn_mfma_f32_16x16x32_bf16(Ef[kk], Af[mb][kk], acc, 0, 0, 0);
                *(LAS f32x4*)(Hl + (16 * mb + fr) * HL_LD + 16 * wid + 4 * fq) = acc; }
            __syncthreads();
            if (blk < 4) {
                if (wid == 0) {
#pragma unroll 8
                    for (int c = 0; c < 64; ++c) { const float hr = Hl[c * HL_LD + p], hi = Hl[c * HL_LD + 64 + p];
                        Hp[c * HP_LD + p] = (bf16)f2bf(cr); Hp[c * HP_LD + 64 + p] = (bf16)f2bf(ci);
                        const float ncr = Ar * cr - Ai * ci + hr, nci = Ar * ci + Ai * cr + hi; cr = ncr; ci = nci; }
                    if (blk == 3) { P.out[O_REP + (size_t)(b * NG + g) * SP + p] = cr; P.out[O_IMP + (size_t)(b * NG + g) * SP + p] = ci; }
                }
            } else {
                for (int c = wid; c < 16; c += NWAVES) { const size_t si = ((size_t)(16 * b + c) * NG + g) * SP + p;
                    const float h0r = P.in[I_SRE][si], h0i = P.in[I_SIM][si];
                    Hp[c * HP_LD + p] = (bf16)f2bf(h0r); Hp[c * HP_LD + 64 + p] = (bf16)f2bf(h0i);
                    P.out[O_RES + si] = Ar * h0r - Ai * h0i + Hl[c * HL_LD + p]; P.out[O_IMS + si] = Ar * h0i + Ai * h0r + Hl[c * HL_LD + 64 + p]; }
            }
            __syncthreads();
#pragma unroll
            for (int mb = 0; mb < 4; ++mb) if (mb < nmb) { f32x4 acc = (f32x4){0.f, 0.f, 0.f, 0.f};
#pragma unroll
                for (int kk = 0; kk < 4; ++kk) acc = __builtin_amdgcn_mfma_f32_16x16x32_bf16(B3f[kk], Af[mb][kk], acc, 0, 0, 0);
#pragma unroll
                for (int kk = 0; kk < 4; ++kk) { const bf16x8 hp = *(const LAS bf16x8*)(Hp + (16 * mb + fr) * HP_LD + 32 * kk + 8 * fq); acc = __builtin_amdgcn_mfma_f32_16x16x32_bf16(B3f[4 + kk], hp, acc, 0, 0, 0); }
                const int tok = tok0 + 8 * (16 * mb + fr) + wid;
                *(v2u*)(Z + (size_t)tok * 512 + 16 * g + 4 * fq) = (v2u){pk2(gelu_tanh(acc[0]), gelu_tanh(acc[1])), pk2(gelu_tanh(acc[2]), gelu_tanh(acc[3]))}; }
            __syncthreads();
        }
    }
}
__device__ __forceinline__ void conv_rows(const Params& P, int cw, int ncw) {
    const int lane = threadIdx.x & 63, ch = 8 * lane;
    unsigned char* ws = P.ws; const bf16* BG = (const bf16*)(ws + WS_BG); const bf16* V = (const bf16*)(ws + WS_V); bf16* MIX = (bf16*)(ws + WS_MIX);
    const float* cwp = P.in[I_CONVW];
    float w0[8], w1[8], w2[8];
#pragma unroll
    for (int i = 0; i < 8; ++i) { w0[i] = cwp[ch + i]; w1[i] = cwp[512 + ch + i]; w2[i] = cwp[1024 + ch + i]; }
    for (int row = cw; row < MTOT; row += ncw) {
        int t, L; const float* past = nullptr; float* cnew;
        if (row < MP) { t = row & (SEQ - 1); L = SEQ; cnew = P.out + O_CONVP + (size_t)(row >> 11) * 2 * WC; }
        else { const int rs = row - MP; t = rs & 7; L = DSEQ; past = P.in[I_CCONV] + (size_t)(rs >> 3) * 2 * WC; cnew = P.out + O_CONVS + (size_t)(rs >> 3) * 2 * WC; }
        float va[8], vb[8], vc[8];
        { const v4u c4 = *(const v4u*)(V + (size_t)row * 512 + ch); vc[0] = pg8::bf_lo(c4.x); vc[1] = pg8::bf_hi(c4.x); vc[2] = pg8::bf_lo(c4.y); vc[3] = pg8::bf_hi(c4.y); vc[4] = pg8::bf_lo(c4.z); vc[5] = pg8::bf_hi(c4.z); vc[6] = pg8::bf_lo(c4.w); vc[7] = pg8::bf_hi(c4.w); }
        if (t >= 1) { const v4u c4 = *(const v4u*)(V + (size_t)(row - 1) * 512 + ch); vb[0] = pg8::bf_lo(c4.x); vb[1] = pg8::bf_hi(c4.x); vb[2] = pg8::bf_lo(c4.y); vb[3] = pg8::bf_hi(c4.y); vb[4] = pg8::bf_lo(c4.z); vb[5] = pg8::bf_hi(c4.z); vb[6] = pg8::bf_lo(c4.w); vb[7] = pg8::bf_hi(c4.w); }
        else {
#pragma unroll
            for (int i = 0; i < 8; ++i) vb[i] = past ? past[WC + ch + i] : 0.f; }
        if (t >= 2) { const v4u c4 = *(const v4u*)(V + (size_t)(row - 2) * 512 + ch); va[0] = pg8::bf_lo(c4.x); va[1] = pg8::bf_hi(c4.x); va[2] = pg8::bf_lo(c4.y); va[3] = pg8::bf_hi(c4.y); va[4] = pg8::bf_lo(c4.z); va[5] = pg8::bf_hi(c4.z); va[6] = pg8::bf_lo(c4.w); va[7] = pg8::bf_hi(c4.w); }
        else {
#pragma unroll
            for (int i = 0; i < 8; ++i) va[i] = past ? past[t * WC + ch + i] : 0.f; }
        const v4u b4 = *(const v4u*)(BG + (size_t)row * 512 + ch);
        float bg[8] = {pg8::bf_lo(b4.x), pg8::bf_hi(b4.x), pg8::bf_lo(b4.y), pg8::bf_hi(b4.y), pg8::bf_lo(b4.z), pg8::bf_hi(b4.z), pg8::bf_lo(b4.w), pg8::bf_hi(b4.w)};
        float o[8];
#pragma unroll
        for (int i = 0; i < 8; ++i) o[i] = bg[i] * (w0[i] * va[i] + w1[i] * vb[i] + w2[i] * vc[i]);
        *(v4u*)(MIX + (size_t)row * 1024 + ch) = (v4u){pk2(o[0], o[1]), pk2(o[2], o[3]), pk2(o[4], o[5]), pk2(o[6], o[7])};
        if (t >= L - 2) { float* d = cnew + (size_t)(t - (L - 2)) * WC + ch; *(f32x4*)d = (f32x4){vc[0], vc[1], vc[2], vc[3]}; *(f32x4*)(d + 4) = (f32x4){vc[4], vc[5], vc[6], vc[7]}; }
    }
}
__device__ __forceinline__ void final_norm(const Params& P, int gw, int NGW) {
    const int lane = threadIdx.x & 63;
    const unsigned long long* SS2 = (const unsigned long long*)(P.ws + WS_SS2);
    const f32x4* gr = (const f32x4*)P.in[I_NFIN] + lane;
    f32x4 gg[4];
#pragma unroll
    for (int j = 0; j < 4; ++j) gg[j] = gr[64 * j];
    for (int m = gw; m < MTOT; m += NGW) { f32x4* xr = (f32x4*)(P.out + (size_t)m * D) + lane;
        const float rstd = 1.0f / sqrtf((float)SS2[m] * (1.0f / (pg8::SS_SCALE * 1024.0f)) + EPS);
#pragma unroll
        for (int j = 0; j < 4; ++j) { f32x4 v = xr[64 * j]; xr[64 * j] = v * rstd * gg[j]; } }
}

__global__ void __launch_bounds__(NTHR, 2) mega_fwd(Params P) {
    extern __shared__ __attribute__((aligned(16))) unsigned char lds_raw[];
    LAS unsigned char* lds = (LAS unsigned char*)lds_raw;
    const int G = gridDim.x, bx = blockIdx.x;
    const int vcu = (G % 8 == 0) ? (bx % 8) * (G / 8) + bx / 8 : bx;
    const int wave = __builtin_amdgcn_readfirstlane(threadIdx.x >> 6);
    unsigned char* ws = P.ws;
    bf16* XN = (bf16*)(ws + WS_XN);
    volatile LAS unsigned* MISC = (volatile LAS unsigned*)(lds + 131072);
    if (threadIdx.x < 32) MISC[threadIdx.x] = 0u;
    __syncthreads();
    const XcdBarrier bar = xcd_barrier_post((unsigned*)(ws + WS_BAR), MISC + 8);
    p0_prologue(P, lds, vcu, G);
    xcd_barrier(bar);
    { pg8::Gemm g{XN, (const bf16*)(ws + WS_WIN), MTOT, NPROJ, D}; pg8::StaticOrder S; S.init(MTOT, NPROJ, G, bx);
      pg8::EpiProj E{(bf16*)(ws + WS_BG), (bf16*)(ws + WS_V), (bf16*)(ws + WS_UG)};
      pg8::gemm_phase<pg8::EpiProj, pg8::StaticOrder, true, true>(lds, g, S, E); }
    xcd_barrier(bar);
    ssm_phase(P, lds, G);
    xcd_barrier(bar);
    { pg8::Gemm g{(const bf16*)(ws + WS_Z), (const bf16*)(ws + WS_WGLU), MTOT, 512, 512}; pg8::StaticOrder S; S.init(MTOT, 512, G, bx);
      pg8::EpiGlu E{(const bf16*)(ws + WS_Z), P.in[I_BGLU], (bf16*)(ws + WS_MIX)};
      pg8::gemm_phase<pg8::EpiGlu, pg8::StaticOrder, true, true>(lds, g, S, E);
      const int nglu = (MTOT / 256) * 2, first = (G > nglu) ? nglu : 0;
      if (bx >= first) conv_rows(P, (bx - first) * NWAVES + wave, (G - first) * NWAVES); }
    xcd_barrier(bar);
    { pg8::Gemm g{(const bf16*)(ws + WS_MIX), (const bf16*)(ws + WS_WOUT), MTOT, D, D}; pg8::StaticOrder S; S.init(MTOT, D, G, bx);
      pg8::EpiRes<true> E{P.in[I_XP], P.in[I_XS], P.out + O_Y, XN, (unsigned long long*)(ws + WS_SS1)};
      pg8::gemm_phase<pg8::EpiRes<true>, pg8::StaticOrder, true, true>(lds, g, S, E); }
    xcd_barrier(bar);
    { pg8::Gemm g{XN, (const bf16*)(ws + WS_WGU), MTOT, NGU, D}; pg8::StaticOrder S; S.init(MTOT, NGU, G, bx);
      pg8::EpiFfn1 E{(const unsigned long long*)(ws + WS_SS1), (bf16*)(ws + WS_H)};
      pg8::gemm_phase<pg8::EpiFfn1, pg8::StaticOrder, true, true>(lds, g, S, E); }
    xcd_barrier(bar);
    { pg8::Gemm g{(const bf16*)(ws + WS_H), (const bf16*)(ws + WS_WDN), MTOT, D, DFF}; pg8::StaticOrder S; S.init(MTOT, D, G, bx);
      pg8::EpiRes<false> E{P.out + O_Y, P.out + O_Y + (size_t)MP * D, P.out + O_Y, nullptr, (unsigned long long*)(ws + WS_SS2)};
      pg8::gemm_phase<pg8::EpiRes<false>, pg8::StaticOrder, true, true>(lds, g, S, E); }
    xcd_barrier(bar);
    final_norm(P, vcu * NWAVES + wave, G * NWAVES);
}

extern "C" void kernel_launch(void* const* d_in, const int* in_sizes, int n_in, void* d_out, int out_size, void* d_ws, size_t ws_size, hipStream_t stream) {
    static int grid = 0;
    if (grid == 0) {
        if (n_in != 24 || in_sizes[0] != MP * D || (size_t)out_size != O_END || ws_size < WS_END) { fprintf(stderr, "kernel_launch: unexpected shapes (n_in %d, in0 %d, out %d, ws %zu); nothing launched\n", n_in, n_in > 0 ? in_sizes[0] : -1, out_size, ws_size); grid = -1; return; }
        int dev = 0, cus = 0, per_cu = 0;
        if (hipGetDevice(&dev) != hipSuccess || hipDeviceGetAttribute(&cus, hipDeviceAttributeMultiprocessorCount, dev) != hipSuccess) { fprintf(stderr, "kernel_launch: device query failed\n"); grid = -1; return; }
        if (hipFuncSetAttribute((const void*)mega_fwd, hipFuncAttributeMaxDynamicSharedMemorySize, LDS_BYTES) != hipSuccess) { fprintf(stderr, "kernel_launch: hipFuncSetAttribute failed\n"); grid = -1; return; }
        if (hipOccupancyMaxActiveBlocksPerMultiprocessor(&per_cu, (const void*)mega_fwd, NTHR, LDS_BYTES) != hipSuccess || per_cu < 1) { fprintf(stderr, "kernel_launch: occupancy query reports %d workgroups per CU\n", per_cu); (void)hipGetLastError(); grid = -1; return; }
        grid = cus * 1;
    }
    if (grid < 0) return;
    if (hipMemsetAsync(d_ws, 0, CTL_ZERO_BYTES, stream) != hipSuccess) { fprintf(stderr, "kernel_launch: memset failed\n"); return; }
    Params p{};
    for (int i = 0; i < 24; ++i) p.in[i] = (const float*)d_in[i];
    p.out = (float*)d_out; p.ws = (unsigned char*)d_ws;
    void* args[] = {&p};
    const hipError_t e = hipLaunchCooperativeKernel((const void*)mega_fwd, dim3(grid), dim3(NTHR), args, LDS_BYTES, stream);
    if (e != hipSuccess) fprintf(stderr, "kernel_launch: cooperative launch failed: %s (grid %d)\n", hipGetErrorString(e), grid);
}
```
